# Optimizing an MI355X kernel written in HIP

```python
import jax
import jax.numpy as jnp
from jax import lax
import numpy as np

D_MODEL = 1024
BATCH = 8
SEQ = 2048
DEPTH = 4

N_MIXERS = 3
NORM_EPS = 1e-6
ROPE_THETA = 10000.0

RET_HEADS = 4
RET_QK_DIM = D_MODEL // RET_HEADS
RET_V_DIM = 2 * D_MODEL // RET_HEADS
RET_CHUNK = 128

LRU_WIDTH = -(-(4 * D_MODEL // 3) // 256) * 256
LRU_BLOCKS = 8
LRU_BLOCK_W = LRU_WIDTH // LRU_BLOCKS
LRU_C = 8.0
CONV_WIDTH = 4

SWA_HEAD_DIM = 64
SWA_Q_HEADS = D_MODEL // SWA_HEAD_DIM
SWA_KV_HEADS = 4
SWA_GROUP = SWA_Q_HEADS // SWA_KV_HEADS
SWA_WINDOW = 128
SWA_BLOCK = 128

FFN_HIDDEN = -(-(8 * D_MODEL // 3) // 256) * 256

N_RET = len(range(0, DEPTH, N_MIXERS))
N_LRU = len(range(1, DEPTH, N_MIXERS))
N_SWA = len(range(2, DEPTH, N_MIXERS))

kernel_name = 'hybrid_retention_rglru_swa_sink_decoder'


def rms_norm(x, gain):
    xf = x.astype(jnp.float32)
    y = xf * lax.rsqrt(jnp.mean(xf * xf, axis=-1, keepdims=True) + NORM_EPS)
    return (y * gain.astype(jnp.float32)).astype(x.dtype)


def apply_rope(t, positions):
    dh = t.shape[-1]
    half = dh // 2
    inv_freq = ROPE_THETA ** (-jnp.arange(half, dtype=jnp.float32) * 2.0 / dh)
    ang = positions.astype(jnp.float32)[..., None] * inv_freq
    cos = jnp.cos(ang)[:, :, None, :]
    sin = jnp.sin(ang)[:, :, None, :]
    tf = t.astype(jnp.float32)
    t1, t2 = tf[..., :half], tf[..., half:]
    return jnp.concatenate([t1 * cos - t2 * sin, t2 * cos + t1 * sin], axis=-1).astype(t.dtype)


def retention(h, positions, w_in, w_out):
    B, S, _ = h.shape
    H, dk, dv, C = RET_HEADS, RET_QK_DIM, RET_V_DIM, RET_CHUNK
    nc = S // C
    q, k, v, g = jnp.split(h @ w_in, [H * dk, 2 * H * dk, 2 * H * dk + H * dv], axis=-1)
    q = apply_rope(q.reshape(B, S, H, dk), positions)
    k = apply_rope(k.reshape(B, S, H, dk), positions) * (dk ** -0.5)
    v = v.reshape(B, S, H, dv)

    def to_chunks(t):
        return t.reshape(B, nc, C, H, t.shape[-1]).transpose(1, 0, 3, 2, 4)

    log_gamma = jnp.log1p(-(2.0 ** (-5.0 - jnp.arange(H, dtype=jnp.float32))))
    idx = jnp.arange(C, dtype=jnp.float32)
    rel = idx[:, None] - idx[None, :]
    intra = jnp.where(rel >= 0, jnp.exp(jnp.maximum(rel, 0.0) * log_gamma[:, None, None]), 0.0).astype(h.dtype)
    q_decay = jnp.exp((idx + 1.0)[None, :] * log_gamma[:, None]).astype(h.dtype)
    k_decay = jnp.exp((C - 1.0 - idx)[None, :] * log_gamma[:, None]).astype(h.dtype)
    chunk_decay = jnp.exp(C * log_gamma).astype(h.dtype)

    def step(state, inp):
        qi, ki, vi = inp
        scores = jnp.einsum('bhqd,bhkd->bhqk', qi, ki) * intra[None]
        o_inner = jnp.einsum('bhqk,bhkv->bhqv', scores, vi)
        o_cross = jnp.einsum('bhqd,bhdv->bhqv', qi, state) * q_decay[None, :, :, None]
        new_state = state * chunk_decay[None, :, None, None] + jnp.einsum(
            'bhkd,bhkv->bhdv', ki * k_decay[None, :, :, None], vi)
        return new_state, o_inner + o_cross

    state0 = jnp.zeros((B, H, dk, dv), h.dtype)
    _, o = lax.scan(step, state0, (to_chunks(q), to_chunks(k), to_chunks(v)))
    o = o.transpose(1, 0, 3, 2, 4).reshape(B, S, H, dv)
    of = o.astype(jnp.float32)
    o = (of * lax.rsqrt(jnp.mean(of * of, axis=-1, keepdims=True) + NORM_EPS)).astype(h.dtype)
    o = o.reshape(B, S, H * dv) * jax.nn.silu(g)
    return o @ w_out


def rglru_block(h, w_in, conv_w, conv_b, w_r, b_r, w_i, b_i, lam, w_out):
    B, S, _ = h.shape
    gate, u = jnp.split(h @ w_in, 2, axis=-1)
    u = lax.conv_general_dilated(
        u, conv_w[:, None, :].astype(u.dtype), window_strides=(1,),
        padding=[(CONV_WIDTH - 1, 0)], dimension_numbers=('NWC', 'WIO', 'NWC'),
        feature_group_count=LRU_WIDTH) + conv_b
    ub = u.reshape(B, S, LRU_BLOCKS, LRU_BLOCK_W)
    r = jax.nn.sigmoid(jnp.einsum('bsnc,ncd->bsnd', ub, w_r) + b_r).reshape(B, S, LRU_WIDTH)
    i = jax.nn.sigmoid(jnp.einsum('bsnc,ncd->bsnd', ub, w_i) + b_i).reshape(B, S, LRU_WIDTH)
    log_a = (-LRU_C * jax.nn.softplus(-lam.astype(jnp.float32))) * r.astype(jnp.float32)
    a = jnp.exp(log_a)
    b = jnp.sqrt(-jnp.expm1(2.0 * log_a)) * (i * u).astype(jnp.float32)

    def combine(left, right):
        a_l, b_l = left
        a_rt, b_rt = right
        return a_l * a_rt, a_rt * b_l + b_rt

    _, hs = lax.associative_scan(combine, (a, b), axis=1)
    y = hs.astype(h.dtype) * jax.nn.gelu(gate)
    return y @ w_out


def sliding_window_sink_attention(h, positions, w_qkv, b_qkv, sinks, w_out, b_out):
    B, S, _ = h.shape
    Hq, Hkv, G, dh, L = SWA_Q_HEADS, SWA_KV_HEADS, SWA_GROUP, SWA_HEAD_DIM, SWA_BLOCK
    nb = S // L
    q, k, v = jnp.split(h @ w_qkv + b_qkv, [Hq * dh, (Hq + Hkv) * dh], axis=-1)
    q = apply_rope(q.reshape(B, S, Hq, dh), positions) * (dh ** -0.5)
    k = apply_rope(k.reshape(B, S, Hkv, dh), positions)
    v = v.reshape(B, S, Hkv, dh)
    qb = q.reshape(B, nb, L, Hkv, G, dh)
    kb = k.reshape(B, nb, L, Hkv, dh)
    vb = v.reshape(B, nb, L, Hkv, dh)

    def with_prev(t):
        prev = jnp.concatenate([jnp.zeros_like(t[:, :1]), t[:, :-1]], axis=1)
        return jnp.concatenate([prev, t], axis=2)

    kw, vw = with_prev(kb), with_prev(vb)
    scores = jnp.einsum('bnqkgd,bnskd->bnkgqs', qb, kw).astype(jnp.float32)
    qi = jnp.arange(L)[:, None]
    si = jnp.arange(2 * L)[None, :]
    dist = qi + L - si
    in_window = (dist >= 0) & (dist < SWA_WINDOW)
    has_key = (jnp.arange(nb)[:, None, None] > 0) | (si[None] >= L)
    mask = in_window[None] & has_key
    scores = jnp.where(mask[None, :, None, None], scores, -jnp.inf)
    sink = jnp.broadcast_to(sinks.astype(jnp.float32).reshape(1, 1, Hkv, G, 1, 1), scores.shape[:-1] + (1,))
    probs = jax.nn.softmax(jnp.concatenate([scores, sink], axis=-1), axis=-1)[..., :-1].astype(h.dtype)
    o = jnp.einsum('bnkgqs,bnskd->bnqkgd', probs, vw).reshape(B, S, Hq * dh)
    return o @ w_out + b_out


def swiglu_ffn(h, w_gu, w_down):
    gate, up = jnp.split(h @ w_gu, 2, axis=-1)
    return (jax.nn.silu(gate) * up) @ w_down


def setup_inputs(seed: int = 0) -> dict:
    key = jax.random.key(seed)
    ks = jax.random.split(key, 24)
    f32 = jnp.float32

    def dense(k, shape, fan_in):
        return jax.random.normal(k, shape, f32) * (fan_in ** -0.5)

    def small(k, shape, scale):
        return scale * jax.random.normal(k, shape, f32)

    x = jax.random.normal(ks[0], (BATCH, SEQ, D_MODEL), f32)
    start = jax.random.randint(ks[1], (BATCH, 1), 0, SEQ, dtype=jnp.int32)
    positions = start + jnp.arange(SEQ, dtype=jnp.int32)[None, :]
    mix_norm = 1.0 + small(ks[2], (DEPTH, D_MODEL), 0.02)
    ffn_norm = 1.0 + small(ks[3], (DEPTH, D_MODEL), 0.02)
    final_norm = 1.0 + small(ks[4], (D_MODEL,), 0.02)

    ret_in_dim = 2 * RET_HEADS * RET_QK_DIM + 2 * RET_HEADS * RET_V_DIM
    ret_w_in = dense(ks[5], (N_RET, D_MODEL, ret_in_dim), D_MODEL)
    ret_w_out = dense(ks[6], (N_RET, RET_HEADS * RET_V_DIM, D_MODEL), RET_HEADS * RET_V_DIM)

    lru_w_in = dense(ks[7], (N_LRU, D_MODEL, 2 * LRU_WIDTH), D_MODEL)
    lru_conv_w = dense(ks[8], (N_LRU, CONV_WIDTH, LRU_WIDTH), CONV_WIDTH)
    lru_conv_b = small(ks[9], (N_LRU, LRU_WIDTH), 0.01)
    lru_w_r = dense(ks[10], (N_LRU, LRU_BLOCKS, LRU_BLOCK_W, LRU_BLOCK_W), LRU_BLOCK_W)
    lru_b_r = small(ks[11], (N_LRU, LRU_BLOCKS, LRU_BLOCK_W), 0.1)
    lru_w_i = dense(ks[12], (N_LRU, LRU_BLOCKS, LRU_BLOCK_W, LRU_BLOCK_W), LRU_BLOCK_W)
    lru_b_i = small(ks[13], (N_LRU, LRU_BLOCKS, LRU_BLOCK_W), 0.1)
    a_pow_c = jax.random.uniform(ks[14], (N_LRU, LRU_WIDTH), f32, 0.9, 0.999)
    a_base = a_pow_c ** (1.0 / LRU_C)
    lru_lambda = jnp.log(a_base) - jnp.log1p(-a_base)
    lru_w_out = dense(ks[15], (N_LRU, LRU_WIDTH, D_MODEL), LRU_WIDTH)

    qkv_dim = (SWA_Q_HEADS + 2 * SWA_KV_HEADS) * SWA_HEAD_DIM
    swa_w_qkv = dense(ks[16], (N_SWA, D_MODEL, qkv_dim), D_MODEL)
    swa_b_qkv = small(ks[17], (N_SWA, qkv_dim), 0.01)
    swa_sinks = small(ks[18], (N_SWA, SWA_Q_HEADS), 0.5)
    swa_w_out = dense(ks[19], (N_SWA, SWA_Q_HEADS * SWA_HEAD_DIM, D_MODEL), SWA_Q_HEADS * SWA_HEAD_DIM)
    swa_b_out = small(ks[20], (N_SWA, D_MODEL), 0.01)

    ffn_w_gu = dense(ks[21], (DEPTH, D_MODEL, 2 * FFN_HIDDEN), D_MODEL)
    ffn_w_down = dense(ks[22], (DEPTH, FFN_HIDDEN, D_MODEL), FFN_HIDDEN)

    return {'x': x, 'positions': positions, 'mix_norm': mix_norm, 'ffn_norm': ffn_norm,
            'final_norm': final_norm, 'ret_w_in': ret_w_in, 'ret_w_out': ret_w_out,
            'lru_w_in': lru_w_in, 'lru_conv_w': lru_conv_w, 'lru_conv_b': lru_conv_b,
            'lru_w_r': lru_w_r, 'lru_b_r': lru_b_r, 'lru_w_i': lru_w_i, 'lru_b_i': lru_b_i,
            'lru_lambda': lru_lambda, 'lru_w_out': lru_w_out, 'swa_w_qkv': swa_w_qkv,
            'swa_b_qkv': swa_b_qkv, 'swa_sinks': swa_sinks, 'swa_w_out': swa_w_out,
            'swa_b_out': swa_b_out, 'ffn_w_gu': ffn_w_gu, 'ffn_w_down': ffn_w_down}


def reference(x, positions, mix_norm, ffn_norm, final_norm, ret_w_in, ret_w_out,
              lru_w_in, lru_conv_w, lru_conv_b, lru_w_r, lru_b_r, lru_w_i, lru_b_i,
              lru_lambda, lru_w_out, swa_w_qkv, swa_b_qkv, swa_sinks, swa_w_out,
              swa_b_out, ffn_w_gu, ffn_w_down):
    for layer in range(DEPTH):
        kind = layer % N_MIXERS
        j = layer // N_MIXERS
        h = rms_norm(x, mix_norm[layer])
        if kind == 0:
            y = retention(h, positions, ret_w_in[j], ret_w_out[j])
        elif kind == 1:
            y = rglru_block(h, lru_w_in[j], lru_conv_w[j], lru_conv_b[j], lru_w_r[j], lru_b_r[j],
                            lru_w_i[j], lru_b_i[j], lru_lambda[j], lru_w_out[j])
        else:
            y = sliding_window_sink_attention(h, positions, swa_w_qkv[j], swa_b_qkv[j],
                                              swa_sinks[j], swa_w_out[j], swa_b_out[j])
        x = x + y
        x = x + swiglu_ffn(rms_norm(x, ffn_norm[layer]), ffn_w_gu[layer], ffn_w_down[layer])
    return rms_norm(x, final_norm)
```

```cpp
#include <hip/hip_runtime.h>
#include <cstdio>
#include <cstdint>
#include <cmath>
namespace pg8 {
#define PG8_LAS __attribute__((address_space(3)))
typedef unsigned short bf16_t;
typedef short bf16x8 __attribute__((ext_vector_type(8)));
typedef float f32x4 __attribute__((ext_vector_type(4)));
typedef unsigned u32x4 __attribute__((ext_vector_type(4)));
constexpr int BM = 256, BK = 64, HALF = 128, HTB = HALF * BK * 2  , STAGE_BYTES = 8 * HTB, NXCD = 8, WGM = 8;

__host__ __device__ __forceinline__ int lds_byte(int r, int c) { const int st = (r >> 4) * 2 + (c >> 5), rr = r & 15, cc = c & 31, ob = rr * 64 + cc * 2; return st * 1024 + (ob ^ (((ob >> 9) & 1) << 5)); }
__host__ __device__ __forceinline__ void stage_rc(int b, int& R, int& C) { const int st = b / 1024, sb = b % 1024, swz = sb ^ (((sb >> 9) & 1) << 5); R = (st >> 1) * 16 + swz / 64; C = (st & 1) * 32 + (swz % 64) / 2; }
__host__ __device__ __forceinline__ int perm32(int rho) { const int n = rho >> 4, i = rho & 15; return 8 * (i >> 2) + 4 * n + (i & 3); }

struct Unit { int pm, pn; };
struct Gemm { const bf16_t* A; const bf16_t* Bt; int M, N, K; };

struct StaticOrder {
    int nM, nN, nwg, G, c;
    __host__ __device__ void init(int M, int N, int G_, int c_) { nM = M / BM; nN = N / BM; nwg = nM * nN; G = G_; c = c_; }
    __host__ __device__ bool next(int i, Unit& u) const {
        const long L = (long)i * G + c; if (L >= nwg) return false;
        int wgid = (int)L; { const int q = nwg / NXCD, r = nwg % NXCD, xcd = wgid % NXCD, off = wgid / NXCD; wgid = (xcd < r ? xcd * (q + 1) : r * (q + 1) + (xcd - r) * q) + off; }
        const int nig = WGM * nN, gid = wgid / nig, fm = gid * WGM, gsz = (nM - fm) < WGM ? (nM - fm) : WGM;
        u.pm = fm + ((wgid % nig) % gsz); u.pn = (wgid % nig) / gsz; return true;
    }
    __device__ __forceinline__ void a_ready(const Unit&) const {}
    __device__ __forceinline__ void done(const Unit&) const {}
};

__device__ __forceinline__ unsigned cvt_pk_bf16(float lo, float hi) { unsigned r; asm volatile("v_cvt_pk_bf16_f32 %0, %1, %2" : "=v"(r) : "v"(lo), "v"(hi)); return r; }
typedef float f32x2 __attribute__((ext_vector_type(2)));
template <class Epi, class Sched, bool ALIGN_EPI = false, bool SP2 = false>
__device__ __forceinline__ void gemm_phase(PG8_LAS unsigned char* lds, const Gemm g, const Sched& S, const Epi& E) {
    int tid_l = threadIdx.x; asm volatile("" : "+v"(tid_l));
    const int tid = tid_l, wid = __builtin_amdgcn_readfirstlane(tid >> 6), lane = tid & 63, wr = wid >> 2, wc = wid & 3, fr = lane & 15, fq = lane >> 4;
    const int K = g.K, nt = K / BK;
    unsigned voffA[2], voffB[2];
#pragma unroll
    for (int i = 0; i < 2; ++i) { int R, C; stage_rc(tid * 16 + i * 8192, R, C); const int Rb = Epi::PERM ? ((R & ~31) + perm32(R & 31)) : R;
        voffA[i] = (unsigned)(R * K + C) * 2u; voffB[i] = (unsigned)(Rb * K + C) * 2u; }
    const size_t kstep = (size_t)(BK * 2);
    const size_t hstep = (size_t)HALF * K * 2;
    const size_t tstep = 2 * hstep;
    const unsigned ldsw = (unsigned)wid * 1024u;
    const int aoff = lds_byte(wr * 64 + fr, fq * 8), boff = lds_byte(wc * 32 + fr, fq * 8);
#define PG8_SA(b, h) (((b) * 2 + (h)) * HTB)
#define PG8_SB(b, h) ((4 + (b) * 2 + (h)) * HTB)
#define PG8_STAGE(bufoff, gbase, voff) do { _Pragma("unroll") for (int _i = 0; _i < 2; ++_i) \
        __builtin_amdgcn_global_load_lds((const unsigned*)((const char*)(gbase) + (voff)[_i]), (PG8_LAS unsigned*)(lds + (bufoff) + ldsw + _i * 8192), 16, 0, 0); } while (0)
#define PG8_LDA(dst, b, h) do { _Pragma("unroll") for (int m = 0; m < 4; ++m) _Pragma("unroll") for (int k = 0; k < 2; ++k) dst[m][k] = *(const PG8_LAS bf16x8*)(lds + PG8_SA(b, h) + aoff + m * 2048 + k * 1024); } while (0)
#define PG8_LDB(dst, b, h) do { _Pragma("unroll") for (int n = 0; n < 2; ++n) _Pragma("unroll") for (int k = 0; k < 2; ++k) dst[n][k] = *(const PG8_LAS bf16x8*)(lds + PG8_SB(b, h) + boff + n * 2048 + k * 1024); } while (0)
#define PG8_MMA(ai, bj, At, Bt) do { __builtin_amdgcn_s_setprio(1); _Pragma("unroll") for (int m = 0; m < 4; ++m) _Pragma("unroll") for (int n = 0; n < 2; ++n) _Pragma("unroll") for (int k = 0; k < 2; ++k) \
        acc[ai][bj][m][n] = __builtin_amdgcn_mfma_f32_16x16x32_bf16(Bt[n][k], At[m][k], acc[ai][bj][m][n], 0, 0, 0); __builtin_amdgcn_s_setprio(0); } while (0)
#define PG8_WAIT_V(n) asm volatile("s_waitcnt vmcnt(" #n ")" ::: "memory")
#define PG8_WAIT_L(n) asm volatile("s_waitcnt lgkmcnt(" #n ")" ::: "memory")
#define PG8_BAR __builtin_amdgcn_s_barrier()
#define PG8_SCHED __builtin_amdgcn_sched_barrier(0)
    Unit cur, nxt; int ui = 0;
    if (!S.next(0, cur)) return;
    f32x4 acc[2][2][4][2];
#pragma unroll
    for (int a = 0; a < 2; ++a)
#pragma unroll
        for (int b = 0; b < 2; ++b)
#pragma unroll
            for (int m = 0; m < 4; ++m)
#pragma unroll
                for (int n = 0; n < 2; ++n) acc[a][b][m][n] = (f32x4){0.f, 0.f, 0.f, 0.f};
    bf16x8 At[4][2], B0[2][2], B1[2][2];
    const char* cA = (const char*)g.A + (size_t)cur.pm * tstep; const char* cB = (const char*)g.Bt + (size_t)cur.pn * tstep;
    S.a_ready(cur);
    if constexpr (SP2) {
        PG8_STAGE(PG8_SB(0, 0), cB, voffB); PG8_STAGE(PG8_SB(0, 1), cB + hstep, voffB); PG8_STAGE(PG8_SA(0, 0), cA, voffA); PG8_STAGE(PG8_SA(0, 1), cA + hstep, voffA);
        if (wr == 1) PG8_BAR;
        PG8_WAIT_V(2); PG8_BAR;
        PG8_STAGE(PG8_SB(1, 0), cB + kstep, voffB); PG8_STAGE(PG8_SA(1, 0), cA + kstep, voffA); PG8_STAGE(PG8_SB(1, 1), cB + hstep + kstep, voffB);
        PG8_WAIT_V(6); PG8_BAR;
    } else {
        PG8_STAGE(PG8_SB(0, 0), cB, voffB); PG8_STAGE(PG8_SA(0, 0), cA, voffA); PG8_STAGE(PG8_SB(0, 1), cB + hstep, voffB); PG8_STAGE(PG8_SA(0, 1), cA + hstep, voffA);
        if (wr == 1) PG8_BAR;
        PG8_WAIT_V(4); PG8_BAR;
        PG8_STAGE(PG8_SB(1, 0), cB + kstep, voffB); PG8_STAGE(PG8_SA(1, 0), cA + kstep, voffA); PG8_STAGE(PG8_SB(1, 1), cB + hstep + kstep, voffB);
        PG8_WAIT_V(6); PG8_BAR;
    }
    for (;;) {
        const bool has_next = S.next(ui + 1, nxt);
        const char* nA = has_next ? (const char*)g.A + (size_t)nxt.pm * tstep : cA; const char* nB = has_next ? (const char*)g.Bt + (size_t)nxt.pn * tstep : cB;
        for (int t = 0; t < nt; t += 2) {
            const bool last = (t == nt - 2);
            const char* a1 = cA + (size_t)(t + 1) * kstep;
            const char* a2 = last ? nA : cA + (size_t)(t + 2) * kstep; const char* b2 = last ? nB : cB + (size_t)(t + 2) * kstep;
            const char* a3 = a2 + kstep; const char* b3 = b2 + kstep;
            if (last && has_next) S.a_ready(nxt);
            if constexpr (SP2) {
            PG8_LDB(B0, 0, 0); PG8_LDB(B1, 0, 1); PG8_SCHED; PG8_LDA(At, 0, 0); PG8_STAGE(PG8_SA(1, 1), a1 + hstep, voffA);
            PG8_WAIT_V(8); PG8_WAIT_L(0); PG8_BAR; PG8_MMA(0, 0, At, B0); PG8_MMA(0, 1, At, B1); PG8_BAR; PG8_SCHED;
            PG8_LDA(At, 0, 1); PG8_STAGE(PG8_SB(0, 0), b2, voffB); PG8_STAGE(PG8_SB(0, 1), b2 + hstep, voffB); PG8_STAGE(PG8_SA(0, 0), a2, voffA);
            PG8_WAIT_V(8); PG8_WAIT_L(0); PG8_BAR; PG8_MMA(1, 0, At, B0); PG8_MMA(1, 1, At, B1); PG8_BAR; PG8_SCHED;
            PG8_LDB(B0, 1, 0); PG8_LDB(B1, 1, 1); PG8_SCHED; PG8_LDA(At, 1, 0); PG8_STAGE(PG8_SA(0, 1), a2 + hstep, voffA);
            PG8_WAIT_V(8); PG8_WAIT_L(0); PG8_BAR; PG8_MMA(0, 0, At, B0); PG8_MMA(0, 1, At, B1); PG8_BAR; PG8_SCHED;
            PG8_LDA(At, 1, 1); PG8_STAGE(PG8_SB(1, 0), b3, voffB); PG8_STAGE(PG8_SB(1, 1), b3 + hstep, voffB); PG8_STAGE(PG8_SA(1, 0), a3, voffA);
            PG8_WAIT_V(8); PG8_WAIT_L(0); PG8_BAR; PG8_MMA(1, 0, At, B0); PG8_MMA(1, 1, At, B1); PG8_BAR; PG8_SCHED;
            } else {
            PG8_LDB(B0, 0, 0); PG8_SCHED; PG8_LDA(At, 0, 0); PG8_STAGE(PG8_SA(1, 1), a1 + hstep, voffA);
            PG8_WAIT_L(8); PG8_BAR; PG8_WAIT_L(0); PG8_MMA(0, 0, At, B0); PG8_BAR; PG8_SCHED;
            PG8_LDB(B1, 0, 1); PG8_STAGE(PG8_SB(0, 0), b2, voffB);
            PG8_BAR; PG8_WAIT_L(0); PG8_MMA(0, 1, At, B1); PG8_BAR;
            PG8_LDA(At, 0, 1); PG8_STAGE(PG8_SA(0, 0), a2, voffA);
            PG8_BAR; PG8_WAIT_L(0); PG8_MMA(1, 0, At, B0); PG8_BAR; PG8_SCHED;
            PG8_STAGE(PG8_SB(0, 1), b2 + hstep, voffB);
            PG8_WAIT_V(6); PG8_BAR; PG8_MMA(1, 1, At, B1); PG8_BAR;
            PG8_LDB(B0, 1, 0); PG8_SCHED; PG8_LDA(At, 1, 0); PG8_STAGE(PG8_SA(0, 1), a2 + hstep, voffA);
            PG8_WAIT_L(8); PG8_BAR; PG8_WAIT_L(0); PG8_MMA(0, 0, At, B0); PG8_BAR; PG8_SCHED;
            PG8_LDB(B1, 1, 1); PG8_STAGE(PG8_SB(1, 0), b3, voffB);
            PG8_BAR; PG8_WAIT_L(0); PG8_MMA(0, 1, At, B1); PG8_BAR;
            PG8_LDA(At, 1, 1); PG8_STAGE(PG8_SA(1, 0), a3, voffA);
            PG8_BAR; PG8_WAIT_L(0); PG8_MMA(1, 0, At, B0); PG8_BAR; PG8_SCHED;
            PG8_STAGE(PG8_SB(1, 1), b3 + hstep, voffB);
            PG8_WAIT_V(6); PG8_BAR; PG8_MMA(1, 1, At, B1); PG8_BAR;
            }
        }
        if constexpr (ALIGN_EPI) { if (wr == 0) PG8_BAR; }
        if constexpr (!Epi::AFTER_DRAIN) { E(acc, cur, wr, wc, fr, fq); S.done(cur); }
        if (!has_next) break;
#pragma unroll
        for (int a = 0; a < 2; ++a)
#pragma unroll
            for (int b = 0; b < 2; ++b)
#pragma unroll
                for (int m = 0; m < 4; ++m)
#pragma unroll
                    for (int n = 0; n < 2; ++n) acc[a][b][m][n] = (f32x4){0.f, 0.f, 0.f, 0.f};
        cur = nxt; cA = nA; cB = nB; ++ui;
        if constexpr (ALIGN_EPI) { if (wr == 1) PG8_BAR; }
    }
    PG8_WAIT_V(0);
    if constexpr (!ALIGN_EPI) { if (wr == 0) PG8_BAR; }
    PG8_BAR;
    if constexpr (Epi::AFTER_DRAIN) { E.fused(acc, cur, wr, wc, fr, fq, lds, wid, lane); S.done(cur); }
#undef PG8_SA
#undef PG8_SB
#undef PG8_STAGE
#undef PG8_LDA
#undef PG8_LDB
#undef PG8_MMA
#undef PG8_WAIT_V
#undef PG8_WAIT_L
#undef PG8_BAR
#undef PG8_SCHED
}
}
namespace pg8 {
typedef unsigned u32x2 __attribute__((ext_vector_type(2)));
__device__ __forceinline__ float bf2f(unsigned b16) { return __uint_as_float(b16 << 16); }
__device__ __forceinline__ float bflo(unsigned w) { return __uint_as_float(w << 16); }
__device__ __forceinline__ float bfhi(unsigned w) { return __uint_as_float(w & 0xffff0000u); }
__device__ __forceinline__ float h2f(unsigned h16) { return (float)__builtin_bit_cast(_Float16, (unsigned short)h16); }
__device__ __forceinline__ float rstd_of(const float* ssq, int row) { const f32x4* p = (const f32x4*)(ssq + (size_t)row * 16); const f32x4 a = p[0], b = p[1], c = p[2], d = p[3];
    const float s = ((a[0] + a[1]) + (a[2] + a[3])) + ((b[0] + b[1]) + (b[2] + b[3])) + ((c[0] + c[1]) + (c[2] + c[3])) + ((d[0] + d[1]) + (d[2] + d[3])); return 1.0f / sqrtf(s * (1.0f / 1024.0f) + 1e-6f); }
__device__ __forceinline__ float silu_f(float x) { return x * __builtin_amdgcn_rcpf(1.0f + __builtin_amdgcn_exp2f(-1.4426950408889634f * x)); }
__device__ __forceinline__ u32x4 pack8(const f32x4& a, const f32x4& b) { u32x4 w; w.x = cvt_pk_bf16(a[0], a[1]); w.y = cvt_pk_bf16(a[2], a[3]); w.z = cvt_pk_bf16(b[0], b[1]); w.w = cvt_pk_bf16(b[2], b[3]); return w; }

struct EpiRetQKV {
    static constexpr bool PERM = true, AFTER_DRAIN = false;
    bf16_t *q, *k, *v; const float* ssq; const unsigned* rope;
    __device__ __forceinline__ void operator()(const f32x4 (&acc)[2][2][4][2], const Unit& u, int wr, int wc, int fr, int fq) const {
        const int t = u.pn; bf16_t* base; int ldc, colt;
        if (t < 4) { base = q; ldc = 1024; colt = t * 256; } else if (t < 8) { base = k; ldc = 1024; colt = (t - 4) * 256; } else { base = v; ldc = 2048; colt = (t - 8) * 256; }
        const bool rp = t < 8;
        const int row0 = u.pm * BM + wr * 64 + fr, d0 = wc * 32 + 8 * fq, col0 = colt + d0;
#pragma unroll
        for (int ai = 0; ai < 2; ++ai)
#pragma unroll
            for (int m = 0; m < 4; ++m) {
                const int row = row0 + ai * HALF + m * 16; const float rs = rstd_of(ssq, row);
                f32x4 v0[2], v1[2];
#pragma unroll
                for (int n = 0; n < 2; ++n) { v0[n] = acc[ai][0][m][n] * rs; v1[n] = acc[ai][1][m][n] * rs; }
                if (rp) {
#pragma unroll
                    for (int n = 0; n < 2; ++n) { const u32x4 cs = *(const u32x4*)(rope + (size_t)row * 128 + d0 + 4 * n);
#pragma unroll
                        for (int e = 0; e < 4; ++e) { const float c = h2f(cs[e] & 0xffffu), s = h2f(cs[e] >> 16), a = v0[n][e], b = v1[n][e]; v0[n][e] = a * c - b * s; v1[n][e] = b * c + a * s; } }
                }
                bf16_t* rowp = base + (size_t)row * ldc + col0;
                *(u32x4*)(rowp) = pack8(v0[0], v0[1]); *(u32x4*)(rowp + HALF) = pack8(v1[0], v1[1]);
            }
    }
};

struct EpiGate {
    static constexpr bool PERM = true, AFTER_DRAIN = false;
    bf16_t* O; const float* ssq;
    __device__ __forceinline__ void operator()(const f32x4 (&acc)[2][2][4][2], const Unit& u, int wr, int wc, int fr, int fq) const {
        const int row0 = u.pm * BM + wr * 64 + fr, col0 = u.pn * BM + wc * 32 + 8 * fq;
#pragma unroll
        for (int ai = 0; ai < 2; ++ai)
#pragma unroll
            for (int m = 0; m < 4; ++m) {
                const int row = row0 + ai * HALF + m * 16; const float rs = rstd_of(ssq, row);
#pragma unroll
                for (int bj = 0; bj < 2; ++bj) { bf16_t* p = O + (size_t)row * 2048 + col0 + bj * HALF; const u32x4 ov = *(const u32x4*)p; f32x4 r[2];
#pragma unroll
                    for (int n = 0; n < 2; ++n)
#pragma unroll
                        for (int e = 0; e < 4; ++e) { const unsigned w = ov[2 * n + (e >> 1)]; const float o = (e & 1) ? bfhi(w) : bflo(w); r[n][e] = o * silu_f(acc[ai][bj][m][n][e] * rs); }
                    *(u32x4*)p = pack8(r[0], r[1]); }
            }
    }
};

struct EpiSwiGLU {
    static constexpr bool PERM = true, AFTER_DRAIN = false;
    bf16_t* Hb; const float* ssq;
    __device__ __forceinline__ void operator()(const f32x4 (&acc)[2][2][4][2], const Unit& u, int wr, int wc, int fr, int fq) const {
        const int row0 = u.pm * BM + wr * 64 + fr, col0 = u.pn * HALF + wc * 32 + 8 * fq;
#pragma unroll
        for (int ai = 0; ai < 2; ++ai)
#pragma unroll
            for (int m = 0; m < 4; ++m) {
                const int row = row0 + ai * HALF + m * 16; const float rs = rstd_of(ssq, row); f32x4 r[2];
#pragma unroll
                for (int n = 0; n < 2; ++n)
#pragma unroll
                    for (int e = 0; e < 4; ++e) r[n][e] = silu_f(acc[ai][0][m][n][e] * rs) * (acc[ai][1][m][n][e] * rs);
                *(u32x4*)(Hb + (size_t)row * 2816 + col0) = pack8(r[0], r[1]);
            }
    }
};

struct EpiLruIn {
    static constexpr bool PERM = true, AFTER_DRAIN = false;
    bf16_t *gate, *uraw; const float* ssq;
    __device__ __forceinline__ void operator()(const f32x4 (&acc)[2][2][4][2], const Unit& u, int wr, int wc, int fr, int fq) const {
        const int t = u.pn; bf16_t* base = t < 6 ? gate : uraw; const int colt = (t < 6 ? t : t - 6) * 256;
        const int row0 = u.pm * BM + wr * 64 + fr, col0 = colt + wc * 32 + 8 * fq;
#pragma unroll
        for (int ai = 0; ai < 2; ++ai)
#pragma unroll
            for (int m = 0; m < 4; ++m) {
                const int row = row0 + ai * HALF + m * 16; const float rs = rstd_of(ssq, row);
                bf16_t* rowp = base + (size_t)row * 1536 + col0;
#pragma unroll
                for (int bj = 0; bj < 2; ++bj) *(u32x4*)(rowp + bj * HALF) = pack8(acc[ai][bj][m][0] * rs, acc[ai][bj][m][1] * rs);
            }
    }
};

struct EpiSwaQKV {
    static constexpr bool PERM = true, AFTER_DRAIN = false;
    bf16_t *q, *k, *v; const float* ssq; const unsigned* rope; const float* bias;
    __device__ __forceinline__ void operator()(const f32x4 (&acc)[2][2][4][2], const Unit& u, int wr, int wc, int fr, int fq) const {
        const int t = u.pn; bf16_t* base; int ldc, colt; float sc = 1.0f;
        if (t < 4) { base = q; ldc = 1024; colt = t * 256; sc = 0.125f; } else if (t == 4) { base = k; ldc = 256; colt = 0; } else { base = v; ldc = 256; colt = 0; }
        const bool rp = t < 5;
        const int row0 = u.pm * BM + wr * 64 + fr, d0 = 8 * fq, ncol0 = 64 * wc + 8 * fq;
#pragma unroll
        for (int ai = 0; ai < 2; ++ai)
#pragma unroll
            for (int m = 0; m < 4; ++m) {
                asm volatile("" ::: "memory");
                const int row = row0 + ai * HALF + m * 16; const float rs = rstd_of(ssq, row);
                f32x4 v0[2], v1[2];
#pragma unroll
                for (int n = 0; n < 2; ++n) { v0[n] = acc[ai][0][m][n] * rs + *(const f32x4*)(bias + t * 256 + ncol0 + 4 * n); v1[n] = acc[ai][1][m][n] * rs + *(const f32x4*)(bias + t * 256 + ncol0 + 32 + 4 * n); }
                if (rp) {
#pragma unroll
                    for (int n = 0; n < 2; ++n) { const u32x4 cs = *(const u32x4*)(rope + (size_t)row * 32 + d0 + 4 * n);
#pragma unroll
                        for (int e = 0; e < 4; ++e) { const float c = h2f(cs[e] & 0xffffu), s = h2f(cs[e] >> 16), a = v0[n][e], b = v1[n][e]; v0[n][e] = (a * c - b * s) * sc; v1[n][e] = (b * c + a * s) * sc; } }
                }
                bf16_t* rowp = base + (size_t)row * ldc + colt + ncol0;
                *(u32x4*)(rowp) = pack8(v0[0], v0[1]); *(u32x4*)(rowp + 32) = pack8(v1[0], v1[1]);
            }
    }
};

struct EpiRes {
    static constexpr bool PERM = false, AFTER_DRAIN = false;
    const float* base; float* out; bf16_t* xn; float* ssq; const float* bias;
    __device__ __forceinline__ void operator()(const f32x4 (&acc)[2][2][4][2], const Unit& u, int wr, int wc, int fr, int fq) const {
        const int col0 = u.pn * BM + wc * 32 + 4 * fq;
        f32x4 bv[2][2];
#pragma unroll
        for (int bj = 0; bj < 2; ++bj)
#pragma unroll
            for (int n = 0; n < 2; ++n) bv[bj][n] = bias ? *(const f32x4*)(bias + col0 + bj * HALF + n * 16) : (f32x4){0.f, 0.f, 0.f, 0.f};
#pragma unroll
        for (int ai = 0; ai < 2; ++ai)
#pragma unroll
            for (int m = 0; m < 4; ++m) {
                const int row = u.pm * BM + ai * HALF + wr * 64 + m * 16 + fr; const size_t off = (size_t)row * 1024 + col0; float s = 0.f;
#pragma unroll
                for (int bj = 0; bj < 2; ++bj)
#pragma unroll
                    for (int n = 0; n < 2; ++n) { const f32x4 b = *(const f32x4*)(base + off + bj * HALF + n * 16); const f32x4 x = acc[ai][bj][m][n] + b + bv[bj][n];
                        *(f32x4*)(out + off + bj * HALF + n * 16) = x; u32x2 w; w.x = cvt_pk_bf16(x[0], x[1]); w.y = cvt_pk_bf16(x[2], x[3]); *(u32x2*)(xn + off + bj * HALF + n * 16) = w;
                        s += (x[0] * x[0] + x[1] * x[1]) + (x[2] * x[2] + x[3] * x[3]); }
                s += __shfl_xor(s, 16); s += __shfl_xor(s, 32);
                if (fq == 0) ssq[(size_t)row * 16 + u.pn * 4 + wc] = s;
            }
    }
};
}
#define GAS __attribute__((address_space(1)))
#define LAS __attribute__((address_space(3)))
typedef unsigned short bf16;
typedef unsigned v4u __attribute__((ext_vector_type(4)));
typedef float f32x4 __attribute__((ext_vector_type(4)));
typedef short bf16x8 __attribute__((ext_vector_type(8)));
typedef GAS unsigned gu32;
typedef GAS unsigned long long gu64;
#define RLX_AGENT __ATOMIC_RELAXED, __HIP_MEMORY_SCOPE_AGENT
#define LDS_WAIT() asm volatile("s_waitcnt lgkmcnt(0)" ::: "memory")
#define VM_WAIT() asm volatile("s_waitcnt vmcnt(0)" ::: "memory")
__device__ __forceinline__ unsigned long long rt() { return __builtin_amdgcn_s_memrealtime(); }
__device__ __forceinline__ unsigned f2bf(float f) { unsigned u = __builtin_bit_cast(unsigned, f); return (u + 0x7fffu + ((u >> 16) & 1u)) >> 16; }
__device__ __forceinline__ unsigned pk2(float lo, float hi) { return f2bf(lo) | (f2bf(hi) << 16); }

#define XB_TMO      128
#define XB_XCNT(j)  (256  + 64 * (j))
#define XB_XSUB(j)  (1280 + 64 * (j))
#define XB_XGEN(j)  (2304 + 64 * (j))
#define XB_TOP      3328
#define XB_TOPGEN   3392
#define XCD_BAR_WORDS 3456
#define XB_SPIN_CAP (1u << 18)

__device__ __forceinline__ unsigned xb_ld(unsigned* p)              { return __hip_atomic_load(p, __ATOMIC_RELAXED, __HIP_MEMORY_SCOPE_AGENT); }
__device__ __forceinline__ unsigned xb_add(unsigned* p, unsigned v) { return __hip_atomic_fetch_add(p, v, __ATOMIC_RELAXED, __HIP_MEMORY_SCOPE_AGENT); }
__device__ __forceinline__ unsigned xb_xcc_id() { return (unsigned)__builtin_amdgcn_s_getreg((3 << 11) | 20) & 0xFu; }
#define XB_SPIN(cond, bar) do { unsigned _sp = 0; while (cond) { __builtin_amdgcn_s_sleep(1); \
    if ((++_sp & 255u) == 0u) { if (xb_ld(&(bar)[XB_TMO])) break; if (_sp > XB_SPIN_CAP) { atomicAdd(&(bar)[XB_TMO], 1u); break; } } } } while (0)

struct XcdBarrier {
    unsigned* bar; unsigned x;
    volatile LAS unsigned* st;
};

__device__ __forceinline__ XcdBarrier xcd_barrier_post(unsigned* bar, volatile LAS unsigned* st) {
    XcdBarrier b; b.bar = bar; b.x = xb_xcc_id(); b.st = st;
    if (threadIdx.x == 0) (void)xb_add(&bar[XB_XCNT(b.x)], 1u);
    return b;
}
__device__ __forceinline__ void xcd_barrier_complete(unsigned* bar, unsigned x, unsigned& nloc, unsigned& nx) {
    const unsigned G = gridDim.x * gridDim.y * gridDim.z;
    unsigned sum, cnt, mine, sp = 0u;
    for (;;) {
        sum = 0u; cnt = 0u; mine = 0u;
#pragma unroll
        for (unsigned j = 0; j < 16; ++j) { const unsigned c = xb_ld(&bar[XB_XCNT(j)]); sum += c; cnt += (c > 0u) ? 1u : 0u; mine = (j == x) ? c : mine; }
        if (sum == G) break;
        __builtin_amdgcn_s_sleep(1);
        if ((++sp & 255u) == 0u) { if (xb_ld(&bar[XB_TMO])) break; if (sp > XB_SPIN_CAP) { atomicAdd(&bar[XB_TMO], 1u); break; } }
    }
    nloc = mine > 0u ? mine : 1u; nx = cnt > 0u ? cnt : 1u;
}

__device__ __forceinline__ void xcd_barrier(const XcdBarrier& b) {
    asm volatile("s_waitcnt vmcnt(0)" ::: "memory");
    __syncthreads();
    if (threadIdx.x == 0) {
        unsigned* bar = b.bar;
        __builtin_amdgcn_s_waitcnt(0);
        unsigned nloc = b.st[0], nx = b.st[1];
        if (nloc == 0u) { xcd_barrier_complete(bar, b.x, nloc, nx); b.st[0] = nloc; b.st[1] = nx; }
        const unsigned old = xb_add(&bar[XB_XSUB(b.x)], 1u);
        const unsigned gen = old / nloc;
        if (old + 1u == (gen + 1u) * nloc) {
            __builtin_amdgcn_fence(__ATOMIC_RELEASE, "agent");
            asm volatile("s_waitcnt vmcnt(0)" ::: "memory");
            const unsigned og = xb_add(&bar[XB_TOP], 1u);
            const unsigned tg = og / nx;
            if (og + 1u == (tg + 1u) * nx) xb_add(&bar[XB_TOPGEN], 1u);
            else XB_SPIN(xb_ld(&bar[XB_TOPGEN]) == tg, bar);
            __builtin_amdgcn_fence(__ATOMIC_ACQUIRE, "agent");
            xb_add(&bar[XB_XGEN(b.x)], 1u);
            asm volatile("s_waitcnt vmcnt(0)" ::: "memory");
        } else {
            XB_SPIN(xb_ld(&bar[XB_XGEN(b.x)]) == gen, bar);
            __builtin_amdgcn_fence(__ATOMIC_ACQUIRE, "agent");
            asm volatile("s_waitcnt vmcnt(0)" ::: "memory");
        }
    }
    __syncthreads();
}
constexpr int NWAVES = 8;
constexpr int BATCH = 8, SEQ = 2048, DM = 1024, M = BATCH * SEQ, DEPTH = 4;
constexpr int RET_H = 4, RET_DK = 256, RET_DV = 512, RET_C = 128;
constexpr int LRU_W = 1536, LRU_NB = 8, LRU_BW = 192;
constexpr int SWA_DH = 64, SWA_HQ = 16, SWA_HKV = 4, SWA_WIN = 128;
constexpr int FFN_H = 2816;
constexpr int N_IN = 23;
enum In { I_X = 0, I_POS, I_MIXN, I_FFNN, I_FINN, I_RET_WIN, I_RET_WOUT, I_LRU_WIN, I_LRU_CW, I_LRU_CB, I_LRU_WR, I_LRU_BR, I_LRU_WI, I_LRU_BI, I_LRU_LAM, I_LRU_WOUT,
          I_SWA_WQKV, I_SWA_BQKV, I_SWA_SINK, I_SWA_WOUT, I_SWA_BOUT, I_FFN_WGU, I_FFN_WDN };

constexpr size_t MiB = 1u << 20;
constexpr size_t WS_CTL = 0, CTL_ZERO_BYTES = 64 * 1024;
constexpr size_t WS_SSQ = 1 * MiB;
constexpr size_t WS_W = 3 * MiB;
constexpr size_t WO_RETIN = 0, WO_RETOUT = 12582912, WO_LRUIN = 16777216, WO_LRUOUT = 19922944, WO_SWAQKV = 21495808, WO_SWAOUT = 23068672, WO_FFNGU = 24117248, WO_FFNDN = 47185920, WO_END = 58720256;
constexpr size_t WS_ROPEA = 115 * MiB, WS_ROPEB = 123 * MiB, WS_XN = 125 * MiB, WS_ACT = 157 * MiB, WS_END = 349 * MiB;
static_assert(WS_W + WO_END * 2 <= WS_ROPEA, "weights fit");
constexpr size_t A_RQ = 0, A_RK = 32 * MiB, A_RV = 64 * MiB, A_RO = 128 * MiB;
constexpr size_t A_H = 0;
constexpr size_t A_LG = 0, A_LU = 48 * MiB, A_LUC = 96 * MiB, A_LY = 144 * MiB;
constexpr size_t A_SQ = 0, A_SK = 32 * MiB, A_SV = 40 * MiB, A_SO = 48 * MiB;
constexpr int CW_BAR = 1024;

constexpr int RING_BYTES = 131072;
constexpr int LDSCTL_OFF = RING_BYTES, MISC_OFF = LDSCTL_OFF + 320, LDS_AUX_OFF = LDSCTL_OFF + 1024;
constexpr int LDS_BYTES = 147456;

struct Args { const void* in[N_IN]; float* out; unsigned char* ws; int ph_lo, ph_hi, li, pad; };
typedef const __attribute__((address_space(4))) Args* CArgs;
struct Frame {
    LAS unsigned char* lds;
    volatile LAS unsigned* MISC;
    gu32* ctl;
    int tid, lane, wave, G, bx;
    CArgs ap;
    unsigned char* ws;
};
__device__ __forceinline__ const float* inF(const Frame& F, int i) { return (const float*)F.ap->in[i]; }
__device__ __forceinline__ bf16* wsW(const Frame& F, size_t eoff) { return (bf16*)(F.ws + WS_W) + eoff; }
__device__ __forceinline__ bf16* wsA(const Frame& F, size_t boff) { return (bf16*)(F.ws + WS_ACT + boff); }
__device__ __forceinline__ float* wsSSQ(const Frame& F, int idx) { return (float*)(F.ws + WS_SSQ) + (size_t)(idx & 1) * M * 16; }
__device__ __forceinline__ float bf2f(unsigned b16) { return __uint_as_float(b16 << 16); }
__device__ __forceinline__ float bflo(unsigned w) { return __uint_as_float(w << 16); }
__device__ __forceinline__ float bfhi(unsigned w) { return __uint_as_float(w & 0xffff0000u); }

__device__ __forceinline__ float wave_sum(float v) {
#pragma unroll
    for (int o = 1; o < 64; o <<= 1) v += __shfl_xor(v, o);
    return v;
}
__device__ __forceinline__ float wave_max(float v) {
#pragma unroll
    for (int o = 1; o < 64; o <<= 1) v = fmaxf(v, __shfl_xor(v, o));
    return v;
}

struct Job { const float* W; bf16* WT; const float* gain; int K, Npitch, Nd, map; };
constexpr int NJOBS = 16;
__host__ __device__ constexpr int job_items(int j) {
    return j < 2 ? (1024 / 64) * (6144 / 32) : j < 4 ? (2048 / 64) * (1024 / 32) : j == 4 ? (1024 / 64) * (3072 / 32) : j == 5 ? (1536 / 64) * (1024 / 32) : j == 6 ? (1024 / 64) * (1536 / 32)
         : j == 7 ? (1024 / 64) * (1024 / 32) : j < 12 ? (1024 / 64) * (5632 / 32) : (2816 / 64) * (1024 / 32);
}
__host__ __device__ constexpr int job_items_total() { int s = 0; for (int j = 0; j < NJOBS; ++j) s += job_items(j); return s; }
__device__ __forceinline__ void get_job(const Frame& F, int j, Job& J) {
    if (j < 2)       { J.W = inF(F, I_RET_WIN) + (size_t)j * 1024 * 6144; J.WT = wsW(F, WO_RETIN + (size_t)j * 6144 * 1024); J.gain = inF(F, I_MIXN) + (j == 0 ? 0 : 3) * 1024; J.K = 1024; J.Npitch = 6144; J.Nd = 6144; J.map = 1; }
    else if (j < 4)  { const int q = j - 2; J.W = inF(F, I_RET_WOUT) + (size_t)q * 2048 * 1024; J.WT = wsW(F, WO_RETOUT + (size_t)q * 1024 * 2048); J.gain = nullptr; J.K = 2048; J.Npitch = 1024; J.Nd = 1024; J.map = 0; }
    else if (j == 4) { J.W = inF(F, I_LRU_WIN); J.WT = wsW(F, WO_LRUIN); J.gain = inF(F, I_MIXN) + 1 * 1024; J.K = 1024; J.Npitch = 3072; J.Nd = 3072; J.map = 0; }
    else if (j == 5) { J.W = inF(F, I_LRU_WOUT); J.WT = wsW(F, WO_LRUOUT); J.gain = nullptr; J.K = 1536; J.Npitch = 1024; J.Nd = 1024; J.map = 0; }
    else if (j == 6) { J.W = inF(F, I_SWA_WQKV); J.WT = wsW(F, WO_SWAQKV); J.gain = inF(F, I_MIXN) + 2 * 1024; J.K = 1024; J.Npitch = 1536; J.Nd = 1536; J.map = 3; }
    else if (j == 7) { J.W = inF(F, I_SWA_WOUT); J.WT = wsW(F, WO_SWAOUT); J.gain = nullptr; J.K = 1024; J.Npitch = 1024; J.Nd = 1024; J.map = 0; }
    else if (j < 12) { const int l = j - 8; J.W = inF(F, I_FFN_WGU) + (size_t)l * 1024 * 5632; J.WT = wsW(F, WO_FFNGU + (size_t)l * 5632 * 1024); J.gain = inF(F, I_FFNN) + l * 1024; J.K = 1024; J.Npitch = 5632; J.Nd = 5632; J.map = 2; }
    else             { const int l = j - 12; J.W = inF(F, I_FFN_WDN) + (size_t)l * 2816 * 1024; J.WT = wsW(F, WO_FFNDN + (size_t)l * 1024 * 2816); J.gain = nullptr; J.K = 2816; J.Npitch = 1024; J.Nd = 1024; J.map = 0; }
}
__device__ __forceinline__ int src_col(int map, int nd) {
    if (map == 2) { const int pn = nd >> 8, p = nd & 255; return p < 128 ? 128 * pn + p : FFN_H + 128 * pn + (p - 128); }
    if (map == 3) { const int t = nd >> 8, p = nd & 255; return 256 * t + 64 * ((p & 127) >> 5) + 32 * (p >> 7) + (p & 31); }
    return nd;
}
__device__ __forceinline__ void p0_transpose_item(const Job& J, LAS float* scr, int item, int lane) {
    const int nblk = J.Nd / 32, kb = item / nblk, nb = item % nblk, k0 = 64 * kb, nd0 = 32 * nb, ns0 = src_col(J.map, nd0);
    const float cs = (J.map == 1 && nd0 >= 1024 && nd0 < 2048) ? 0.0625f : 1.0f;
#pragma unroll 8
    for (int i = 0; i < 32; ++i) { const int kk = 2 * i + (lane >> 5); const float g = J.gain ? J.gain[k0 + kk] * cs : cs; scr[kk * 33 + (lane & 31)] = J.W[(size_t)(k0 + kk) * J.Npitch + ns0 + (lane & 31)] * g; }
    LDS_WAIT(); asm volatile("" ::: "memory");
    const int c = lane & 7;
#pragma unroll
    for (int j = 0; j < 4; ++j) { const int n = (lane >> 3) + 8 * j; const LAS float* s = scr + (8 * c) * 33 + n;
        v4u o; o.x = pk2(s[0 * 33], s[1 * 33]); o.y = pk2(s[2 * 33], s[3 * 33]); o.z = pk2(s[4 * 33], s[5 * 33]); o.w = pk2(s[6 * 33], s[7 * 33]);
        *(GAS v4u*)(J.WT + (size_t)(nd0 + n) * J.K + k0 + 8 * c) = o; }
    LDS_WAIT(); asm volatile("" ::: "memory");
}
__device__ __forceinline__ unsigned pack_cs(float ang) {
    const float n = rintf(ang * 0.15915494309189535f);
    float r = fmaf(-n, 6.28125f, ang); r = fmaf(-n, 1.9353071795864769e-3f, r);
    const float rev = r * 0.15915494309189535f;
    const float c = __builtin_amdgcn_cosf(rev), s = __builtin_amdgcn_sinf(rev);
    const unsigned short cb = __builtin_bit_cast(unsigned short, (_Float16)c), sb = __builtin_bit_cast(unsigned short, (_Float16)s);
    return (unsigned)cb | ((unsigned)sb << 16);
}
__device__ __forceinline__ void p0_prologue(Frame& F) {
    LAS float* scr = (LAS float*)(F.lds + F.wave * 16384);
    const int gw = F.bx * NWAVES + F.wave, NGW = F.G * NWAVES;
    constexpr int NITEMS = job_items_total();
    for (int it = gw; it < NITEMS; it += NGW) {
        int r = it, j = 0;
        for (; j < NJOBS - 1; ++j) { const int n = job_items(j); if (r < n) break; r -= n; }
        Job J; get_job(F, j, J);
        p0_transpose_item(J, scr, r, F.lane);
    }
    const int* pos = (const int*)F.ap->in[I_POS];
    unsigned* ropeA = (unsigned*)(F.ws + WS_ROPEA); unsigned* ropeB = (unsigned*)(F.ws + WS_ROPEB);
    const float* x = inF(F, I_X); bf16* xn = (bf16*)(F.ws + WS_XN); float* ssq0 = wsSSQ(F, 0);
    const float ifA0 = powf(10000.0f, -((float)F.lane * 2.0f / 256.0f)), ifA1 = powf(10000.0f, -((float)(F.lane + 64) * 2.0f / 256.0f)), ifB = powf(10000.0f, -((float)(F.lane & 31) * 2.0f / 64.0f));
    for (int m = gw; m < M; m += NGW) {
        const float p = (float)pos[m];
        ropeA[(size_t)m * 128 + F.lane] = pack_cs(p * ifA0); ropeA[(size_t)m * 128 + 64 + F.lane] = pack_cs(p * ifA1);
        if (F.lane < 32) ropeB[(size_t)m * 32 + F.lane] = pack_cs(p * ifB);
        const GAS f32x4* xr = (const GAS f32x4*)(x + (size_t)m * DM) + F.lane; f32x4 v[4]; float s = 0.f;
#pragma unroll
        for (int j = 0; j < 4; ++j) { v[j] = xr[64 * j]; s += (v[j].x * v[j].x + v[j].y * v[j].y) + (v[j].z * v[j].z + v[j].w * v[j].w); }
        s = wave_sum(s); if (F.lane < 16) ssq0[(size_t)m * 16 + F.lane] = F.lane == 0 ? s : 0.f;
        GAS unsigned long long* o8 = (GAS unsigned long long*)(xn + (size_t)m * DM) + F.lane;
#pragma unroll
        for (int j = 0; j < 4; ++j) o8[64 * j] = (unsigned long long)pk2(v[j].x, v[j].y) | ((unsigned long long)pk2(v[j].z, v[j].w) << 32);
    }
}
__device__ __forceinline__ void final_norm(Frame& F) {
    const int gw = F.bx * NWAVES + F.wave, NGW = F.G * NWAVES; const float* g = inF(F, I_FINN); float* out = F.ap->out;
    f32x4 gv[4];
#pragma unroll
    for (int j = 0; j < 4; ++j) gv[j] = ((const f32x4*)g)[F.lane + 64 * j];
    for (int m = gw; m < M; m += NGW) {
        GAS f32x4* xr = (GAS f32x4*)(out + (size_t)m * DM) + F.lane; f32x4 v[4]; float s = 0.f;
#pragma unroll
        for (int j = 0; j < 4; ++j) { v[j] = xr[64 * j]; s += (v[j].x * v[j].x + v[j].y * v[j].y) + (v[j].z * v[j].z + v[j].w * v[j].w); }
        const float rs = 1.0f / sqrtf(wave_sum(s) * (1.0f / DM) + 1e-6f);
#pragma unroll
        for (int j = 0; j < 4; ++j) xr[64 * j] = v[j] * rs * gv[j];
    }
}

__device__ __forceinline__ void ret_core_naive(Frame& F) {
    const int w = F.bx; if (w >= 256) return;
    const int b = w >> 5, h = (w >> 3) & 3, vs = w & 7, tid = F.tid;
    LAS float* S = (LAS float*)F.lds; LAS float* P = S + 256 * 64; LAS float* kdec = (LAS float*)(F.lds + LDS_AUX_OFF);
    const float lg = log1pf(-exp2f(-5.0f - (float)h));
    for (int i = tid; i < 256 * 64; i += 512) S[i] = 0.f;
    if (tid < 128) kdec[tid] = expf((float)(127 - tid) * lg);
    const float cdec = expf(128.0f * lg);
    __syncthreads();
    const bf16* Q = wsA(F, A_RQ); const bf16* K = wsA(F, A_RK); const bf16* V = wsA(F, A_RV); bf16* O = wsA(F, A_RO);
    for (int c = 0; c < SEQ / RET_C; ++c) {
        const size_t r0 = (size_t)b * SEQ + (size_t)c * RET_C;
        const bf16* qc = Q + r0 * 1024 + h * 256; const bf16* kc = K + r0 * 1024 + h * 256; const bf16* vc = V + r0 * 2048 + h * 512 + vs * 64; bf16* oc = O + r0 * 2048 + h * 512 + vs * 64;
        for (int idx = tid; idx < 128 * 128; idx += 512) {
            const int i = idx >> 7, j = idx & 127; float s = 0.f;
            if (j <= i) {
                const v4u* qp = (const v4u*)(qc + (size_t)i * 1024); const v4u* kp = (const v4u*)(kc + (size_t)j * 1024);
                for (int d8 = 0; d8 < 32; ++d8) { const v4u a = qp[d8], bb = kp[d8];
                    s += bflo(a.x) * bflo(bb.x) + bfhi(a.x) * bfhi(bb.x) + bflo(a.y) * bflo(bb.y) + bfhi(a.y) * bfhi(bb.y) + bflo(a.z) * bflo(bb.z) + bfhi(a.z) * bfhi(bb.z) + bflo(a.w) * bflo(bb.w) + bfhi(a.w) * bfhi(bb.w); }
                s *= expf((float)(i - j) * lg);
            }
            P[idx] = s;
        }
        __syncthreads();
        for (int idx = tid; idx < 128 * 64; idx += 512) {
            const int i = idx >> 6, vv = idx & 63; float inner = 0.f, cross = 0.f;
#pragma unroll 8
            for (int j = 0; j <= i; ++j) inner += P[i * 128 + j] * bf2f(vc[(size_t)j * 2048 + vv]);
#pragma unroll 8
            for (int d = 0; d < 256; ++d) cross += bf2f(qc[(size_t)i * 1024 + d]) * S[d * 64 + vv];
            oc[(size_t)i * 2048 + vv] = (bf16)f2bf(inner + cross * expf((float)(i + 1) * lg));
        }
        __syncthreads();
        for (int idx = tid; idx < 256 * 64; idx += 512) {
            const int d = idx >> 6, vv = idx & 63; float a = 0.f;
#pragma unroll 8
            for (int j = 0; j < 128; ++j) a += bf2f(kc[(size_t)j * 1024 + d]) * kdec[j] * bf2f(vc[(size_t)j * 2048 + vv]);
            S[idx] = S[idx] * cdec + a;
        }
        __syncthreads();
    }
}
__device__ __forceinline__ void ret_norm_naive(Frame& F) {
    const int gw = F.bx * NWAVES + F.wave, NGW = F.G * NWAVES; bf16* V = wsA(F, A_RO);
    for (int it = gw; it < M * RET_H; it += NGW) {
        GAS v4u* p = (GAS v4u*)(V + (size_t)it * 512) + F.lane; const v4u a = *p;
        float f[8] = {bflo(a.x), bfhi(a.x), bflo(a.y), bfhi(a.y), bflo(a.z), bfhi(a.z), bflo(a.w), bfhi(a.w)}; float s = 0.f;
#pragma unroll
        for (int e = 0; e < 8; ++e) s += f[e] * f[e];
        const float rs = 1.0f / sqrtf(wave_sum(s) * (1.0f / 512.0f) + 1e-6f);
        v4u o; o.x = pk2(f[0] * rs, f[1] * rs); o.y = pk2(f[2] * rs, f[3] * rs); o.z = pk2(f[4] * rs, f[5] * rs); o.w = pk2(f[6] * rs, f[7] * rs); *p = o;
    }
}
__device__ __forceinline__ void lru_conv_naive(Frame& F) {
    const bf16* UR = wsA(F, A_LU); bf16* UC = wsA(F, A_LUC); const float* cw = inF(F, I_LRU_CW); const float* cb = inF(F, I_LRU_CB);
    const int gt = F.bx * 512 + F.tid, NGT = F.G * 512;
    for (int it = gt; it < M * (LRU_W / 8); it += NGT) {
        const int row = it / (LRU_W / 8), ch0 = (it % (LRU_W / 8)) * 8, t = row & (SEQ - 1); float a[8];
#pragma unroll
        for (int e = 0; e < 8; ++e) a[e] = cb[ch0 + e];
#pragma unroll
        for (int w = 0; w < 4; ++w) { if (t - 3 + w >= 0) { const v4u u = *(const v4u*)(UR + (size_t)(row - 3 + w) * LRU_W + ch0); const float* c = cw + w * LRU_W + ch0;
            a[0] += c[0] * bflo(u.x); a[1] += c[1] * bfhi(u.x); a[2] += c[2] * bflo(u.y); a[3] += c[3] * bfhi(u.y); a[4] += c[4] * bflo(u.z); a[5] += c[5] * bfhi(u.z); a[6] += c[6] * bflo(u.w); a[7] += c[7] * bfhi(u.w); } }
        v4u o; o.x = pk2(a[0], a[1]); o.y = pk2(a[2], a[3]); o.z = pk2(a[4], a[5]); o.w = pk2(a[6], a[7]); *(v4u*)(UC + (size_t)row * LRU_W + ch0) = o;
    }
}
__device__ __forceinline__ float gelu_tanh(float x) { const float u = 0.7978845608028654f * (x + 0.044715f * x * x * x); const float e = __expf(2.0f * u); const float th = 1.0f - 2.0f / (e + 1.0f); return 0.5f * x * (1.0f + th); }
__device__ __forceinline__ void lru_scan_naive(Frame& F) {
    if (F.bx >= 192 || F.wave != 0) return;
    const int gid = F.bx * 64 + F.lane, b = gid / LRU_W, ch = gid % LRU_W, blk = ch / LRU_BW, dch = ch % LRU_BW;
    const bf16* G = wsA(F, A_LG); const bf16* UC = wsA(F, A_LUC); bf16* Y = wsA(F, A_LY);
    const float* wr = inF(F, I_LRU_WR) + (size_t)blk * LRU_BW * LRU_BW + dch; const float* wi = inF(F, I_LRU_WI) + (size_t)blk * LRU_BW * LRU_BW + dch;
    const float br = inF(F, I_LRU_BR)[ch], bi = inF(F, I_LRU_BI)[ch], lam = inF(F, I_LRU_LAM)[ch];
    const float sp = (lam > 0.f ? 0.f : -lam) + log1pf(expf(-fabsf(lam)));
    const float cneg = -8.0f * sp; float hst = 0.f;
    for (int t = 0; t < SEQ; ++t) {
        const size_t row = (size_t)b * SEQ + t; const bf16* up = UC + row * LRU_W + blk * LRU_BW; float ar = br, ai = bi;
#pragma unroll 16
        for (int c = 0; c < LRU_BW; ++c) { const float uu = bf2f(up[c]); ar += uu * wr[(size_t)c * LRU_BW]; ai += uu * wi[(size_t)c * LRU_BW]; }
        const float r = 1.0f / (1.0f + expf(-ar)), ig = 1.0f / (1.0f + expf(-ai));
        const float la = cneg * r, a = expf(la), bb = sqrtf(-expm1f(2.0f * la)) * (ig * bf2f(UC[row * LRU_W + ch]));
        hst = a * hst + bb;
        Y[row * LRU_W + ch] = (bf16)f2bf(hst * gelu_tanh(bf2f(G[row * LRU_W + ch])));
    }
}
__device__ __forceinline__ void swa_naive(Frame& F) {
    const int gw = F.bx * NWAVES + F.wave, NGW = F.G * NWAVES, lane = F.lane;
    const bf16* Q = wsA(F, A_SQ); const bf16* K = wsA(F, A_SK); const bf16* V = wsA(F, A_SV); bf16* O = wsA(F, A_SO); const float* sinks = inF(F, I_SWA_SINK);
    LAS float* pl = (LAS float*)F.lds + F.wave * 128;
    for (int it = gw; it < M * SWA_HQ; it += NGW) {
        const int row = it >> 4, qh = it & 15, kvh = qh >> 2, t = row & (SEQ - 1);
        const v4u* qp = (const v4u*)(Q + (size_t)row * 1024 + qh * 64); v4u qv[8];
#pragma unroll
        for (int i = 0; i < 8; ++i) qv[i] = qp[i];
        float sc[2];
#pragma unroll
        for (int kk = 0; kk < 2; ++kk) {
            const int dj = 127 - lane - 64 * kk;
            float s = -INFINITY;
            if (t - dj >= 0) { const v4u* kp = (const v4u*)(K + (size_t)(row - dj) * 256 + kvh * 64); s = 0.f;
#pragma unroll
                for (int i = 0; i < 8; ++i) { const v4u a = qv[i], bb = kp[i];
                    s += bflo(a.x) * bflo(bb.x) + bfhi(a.x) * bfhi(bb.x) + bflo(a.y) * bflo(bb.y) + bfhi(a.y) * bfhi(bb.y) + bflo(a.z) * bflo(bb.z) + bfhi(a.z) * bfhi(bb.z) + bflo(a.w) * bflo(bb.w) + bfhi(a.w) * bfhi(bb.w); } }
            sc[kk] = s;
        }
        const float sk = sinks[qh];
        const float mx = fmaxf(wave_max(fmaxf(sc[0], sc[1])), sk);
        const float p0 = expf(sc[0] - mx), p1 = expf(sc[1] - mx);
        const float den = wave_sum(p0 + p1) + expf(sk - mx), inv = 1.0f / den;
        pl[127 - lane] = p0 * inv; pl[63 - lane] = p1 * inv;
        LDS_WAIT(); asm volatile("" ::: "memory");
        float o = 0.f; const int nk = t < 127 ? t + 1 : 128;
#pragma unroll 8
        for (int dj = 0; dj < nk; ++dj) o += pl[dj] * bf2f(V[(size_t)(row - dj) * 256 + kvh * 64 + lane]);
        O[(size_t)row * 1024 + qh * 64 + lane] = (bf16)f2bf(o);
        LDS_WAIT(); asm volatile("" ::: "memory");
    }
}
enum Kind { K_PROLOGUE = 0, K_G_RETQKV, K_RET_CORE, K_RET_NORM, K_G_GATE, K_G_RES, K_G_FFNUP, K_G_LRUIN, K_LRU_CONV, K_LRU_SCAN, K_G_SWAQKV, K_SWA_ATT, K_FINAL };
struct PD { int kind, layer, sub; };
constexpr int N_PHASES = 1 + 7 + 6 + 5 + 7 + 1;
__host__ __device__ __forceinline__ int ret_kind(int p) { return p == 0 ? K_G_RETQKV : p == 1 ? K_RET_CORE : p == 2 ? K_RET_NORM : p == 3 ? K_G_GATE : p == 4 ? K_G_RES : p == 5 ? K_G_FFNUP : K_G_RES; }
__host__ __device__ __forceinline__ int lru_kind(int p) { return p == 0 ? K_G_LRUIN : p == 1 ? K_LRU_CONV : p == 2 ? K_LRU_SCAN : p == 3 ? K_G_RES : p == 4 ? K_G_FFNUP : K_G_RES; }
__host__ __device__ __forceinline__ int swa_kind(int p) { return p == 0 ? K_G_SWAQKV : p == 1 ? K_SWA_ATT : p == 2 ? K_G_RES : p == 3 ? K_G_FFNUP : K_G_RES; }
__host__ __device__ __forceinline__ PD phase_desc(int ph) {
    PD d{K_FINAL, 0, 0};
    if (ph == 0) { d.kind = K_PROLOGUE; return d; }
    int p = ph - 1;
    if (p < 7) { d.layer = 0; d.kind = ret_kind(p); d.sub = (p == 6); return d; } p -= 7;
    if (p < 6) { d.layer = 1; d.kind = lru_kind(p); d.sub = (p == 5); return d; } p -= 6;
    if (p < 5) { d.layer = 2; d.kind = swa_kind(p); d.sub = (p == 4); return d; } p -= 5;
    if (p < 7) { d.layer = 3; d.kind = ret_kind(p); d.sub = (p == 6); return d; }
    return d;
}

__global__ void __launch_bounds__(NWAVES * 64, 2) mk_fwd(Args args_unused) {
    extern __shared__ __attribute__((aligned(16))) unsigned char lds[];
    Frame F;
    F.lds = (LAS unsigned char*)lds; F.MISC = (volatile LAS unsigned*)(F.lds + MISC_OFF);
    F.tid = threadIdx.x; F.lane = F.tid & 63; F.wave = __builtin_amdgcn_readfirstlane(F.tid >> 6); F.G = gridDim.x;
    F.ap = (CArgs)__builtin_amdgcn_kernarg_segment_ptr(); F.ws = F.ap->ws; F.ctl = (gu32*)(F.ws + WS_CTL);
    for (int u = F.tid; u < (LDS_BYTES - LDSCTL_OFF) / 4; u += NWAVES * 64) ((LAS unsigned*)(F.lds + LDSCTL_OFF))[u] = 0u;
    __syncthreads();
    XcdBarrier bar = xcd_barrier_post((unsigned*)(F.ctl + CW_BAR) + F.ap->li * XCD_BAR_WORDS, F.MISC + 8);
    const int ph_hi = F.ap->ph_hi;
    for (int ph = F.ap->ph_lo; ph < ph_hi; ++ph) {
        { int t_ = threadIdx.x; asm volatile("" : "+v"(t_)); F.tid = t_; F.lane = t_ & 63; F.wave = __builtin_amdgcn_readfirstlane(t_ >> 6); int bx_ = blockIdx.x; asm volatile("" : "+s"(bx_)); F.bx = bx_; }
        { CArgs ap_ = (CArgs)__builtin_amdgcn_kernarg_segment_ptr(); asm volatile("" : "+s"(ap_)); F.ap = ap_; unsigned char* ws_ = ap_->ws; asm volatile("" : "+s"(ws_)); F.ws = ws_; }
        bf16* XN = (bf16*)(F.ws + WS_XN); float* const outp = F.ap->out;
        const PD d = phase_desc(ph);
        const int L = d.layer, rj = (L == 3) ? 1 : 0;
        switch (d.kind) {
        case K_PROLOGUE: p0_prologue(F); break;
        case K_G_RETQKV: {
            pg8::Gemm g{XN, wsW(F, WO_RETIN + (size_t)rj * 6144 * 1024), M, 4096, 1024}; pg8::StaticOrder S; S.init(M, 4096, F.G, F.bx);
            pg8::EpiRetQKV E{wsA(F, A_RQ), wsA(F, A_RK), wsA(F, A_RV), wsSSQ(F, 2 * L), (const unsigned*)(F.ws + WS_ROPEA)};
            pg8::gemm_phase<pg8::EpiRetQKV, pg8::StaticOrder, true, true>(F.lds, g, S, E);
        } break;
        case K_RET_CORE: ret_core_naive(F); break;
        case K_RET_NORM: ret_norm_naive(F); break;
        case K_G_GATE: {
            pg8::Gemm g{XN, wsW(F, WO_RETIN + (size_t)rj * 6144 * 1024 + (size_t)4096 * 1024), M, 2048, 1024}; pg8::StaticOrder S; S.init(M, 2048, F.G, F.bx);
            pg8::EpiGate E{wsA(F, A_RO), wsSSQ(F, 2 * L)};
            pg8::gemm_phase<pg8::EpiGate, pg8::StaticOrder, true, true>(F.lds, g, S, E);
        } break;
        case K_G_RES: {
            const bf16* A; const bf16* W; int K; const float* bias = nullptr; int si;
            if (d.sub == 1) { A = wsA(F, A_H); W = wsW(F, WO_FFNDN + (size_t)L * 1024 * 2816); K = 2816; si = 2 * L + 2; }
            else { si = 2 * L + 1;
                if (L == 1) { A = wsA(F, A_LY); W = wsW(F, WO_LRUOUT); K = 1536; }
                else if (L == 2) { A = wsA(F, A_SO); W = wsW(F, WO_SWAOUT); K = 1024; bias = inF(F, I_SWA_BOUT); }
                else { A = wsA(F, A_RO); W = wsW(F, WO_RETOUT + (size_t)rj * 1024 * 2048); K = 2048; } }
            const float* base = (L == 0 && d.sub == 0) ? inF(F, I_X) : (const float*)outp;
            pg8::Gemm g{A, W, M, 1024, K}; pg8::StaticOrder S; S.init(M, 1024, F.G, F.bx);
            pg8::EpiRes E{base, outp, XN, wsSSQ(F, si), bias};
            pg8::gemm_phase<pg8::EpiRes, pg8::StaticOrder, false, true>(F.lds, g, S, E);
        } break;
        case K_G_FFNUP: {
            pg8::Gemm g{XN, wsW(F, WO_FFNGU + (size_t)L * 5632 * 1024), M, 5632, 1024}; pg8::StaticOrder S; S.init(M, 5632, F.G, F.bx);
            pg8::EpiSwiGLU E{wsA(F, A_H), wsSSQ(F, 2 * L + 1)};
            pg8::gemm_phase<pg8::EpiSwiGLU, pg8::StaticOrder, true, true>(F.lds, g, S, E);
        } break;
        case K_G_LRUIN: {
            pg8::Gemm g{XN, wsW(F, WO_LRUIN), M, 3072, 1024}; pg8::StaticOrder S; S.init(M, 3072, F.G, F.bx);
            pg8::EpiLruIn E{wsA(F, A_LG), wsA(F, A_LU), wsSSQ(F, 2 * L)};
            pg8::gemm_phase<pg8::EpiLruIn, pg8::StaticOrder, true, true>(F.lds, g, S, E);
        } break;
        case K_LRU_CONV: lru_conv_naive(F); break;
        case K_LRU_SCAN: lru_scan_naive(F); break;
        case K_G_SWAQKV: {
            pg8::Gemm g{XN, wsW(F, WO_SWAQKV), M, 1536, 1024}; pg8::StaticOrder S; S.init(M, 1536, F.G, F.bx);
            pg8::EpiSwaQKV E{wsA(F, A_SQ), wsA(F, A_SK), wsA(F, A_SV), wsSSQ(F, 2 * L), (const unsigned*)(F.ws + WS_ROPEB), inF(F, I_SWA_BQKV)};
            pg8::gemm_phase<pg8::EpiSwaQKV, pg8::StaticOrder, true, true>(F.lds, g, S, E);
        } break;
        case K_SWA_ATT: swa_naive(F); break;
        default: final_norm(F); break;
        }
        if (ph + 1 < ph_hi) xcd_barrier(bar);
    }
}

extern "C" void kernel_launch(void* const* d_in, const int* in_sizes, int n_in, void* d_out, int out_size, void* d_ws, size_t ws_size, hipStream_t stream) {
    static int grid = 0;
    if (grid == 0) {
        if (n_in != N_IN || in_sizes[0] != M * DM || out_size != M * DM || ws_size < WS_END) { fprintf(stderr, "kernel_launch: unexpected shapes: n_in %d in0 %d out %d ws %zu (need %zu); nothing launched\n", n_in, n_in > 0 ? in_sizes[0] : -1, out_size, ws_size, (size_t)WS_END); grid = -1; return; }
        int dev = 0, cus = 0;
        if (hipGetDevice(&dev) != hipSuccess || hipDeviceGetAttribute(&cus, hipDeviceAttributeMultiprocessorCount, dev) != hipSuccess) { fprintf(stderr, "kernel_launch: device query failed\n"); grid = -1; return; }
        if (hipFuncSetAttribute((const void*)mk_fwd, hipFuncAttributeMaxDynamicSharedMemorySize, LDS_BYTES) != hipSuccess) { fprintf(stderr, "kernel_launch: hipFuncSetAttribute failed\n"); grid = -1; return; }
        int per_cu = 0;
        if (hipOccupancyMaxActiveBlocksPerMultiprocessor(&per_cu, (const void*)mk_fwd, NWAVES * 64, LDS_BYTES) != hipSuccess || per_cu < 1) fprintf(stderr, "kernel_launch: note: occupancy query reports %d workgroups per CU\n", per_cu);
        (void)hipGetLastError();
        grid = cus;
        if (grid != 256) fprintf(stderr, "kernel_launch: note: %d CUs (built for 256)\n", grid);
    }
    if (grid < 0) return;
    if (hipMemsetAsync((char*)d_ws + WS_CTL, 0, CTL_ZERO_BYTES, stream) != hipSuccess) { fprintf(stderr, "kernel_launch: hipMemsetAsync failed\n"); return; }
    Args a{};
    for (int i = 0; i < N_IN; ++i) a.in[i] = d_in[i];
    a.out = (float*)d_out; a.ws = (unsigned char*)d_ws;
#ifndef MK_CUTS
    a.ph_lo = 0; a.ph_hi = N_PHASES; a.li = 0;
    hipLaunchKernelGGL(mk_fwd, dim3(grid), dim3(NWAVES * 64), LDS_BYTES, stream, a);
#else
    for (int ph = 0; ph < N_PHASES; ++ph) { a.ph_lo = ph; a.ph_hi = ph + 1; a.li = 0; hipLaunchKernelGGL(mk_fwd, dim3(grid), dim3(NWAVES * 64), LDS_BYTES, stream, a); }
#endif
    const hipError_t le = hipPeekAtLastError();
    if (le != hipSuccess) fprintf(stderr, "kernel_launch: launch failed: %s\n", hipGetErrorName(le));
}
```

```cpp
#include <hip/hip_runtime.h>
#include <cstdio>
#include <cstdint>
#include <cmath>
namespace pg8 {
#define PG8_LAS __attribute__((address_space(3)))
typedef unsigned short bf16_t;
typedef short bf16x8 __attribute__((ext_vector_type(8)));
typedef float f32x4 __attribute__((ext_vector_type(4)));
typedef unsigned u32x4 __attribute__((ext_vector_type(4)));
constexpr int BM = 256, BK = 64, HALF = 128, HTB = HALF * BK * 2  , STAGE_BYTES = 8 * HTB, NXCD = 8, WGM = 8;

__host__ __device__ __forceinline__ int lds_byte(int r, int c) { const int st = (r >> 4) * 2 + (c >> 5), rr = r & 15, cc = c & 31, ob = rr * 64 + cc * 2; return st * 1024 + (ob ^ (((ob >> 9) & 1) << 5)); }
__host__ __device__ __forceinline__ void stage_rc(int b, int& R, int& C) { const int st = b / 1024, sb = b % 1024, swz = sb ^ (((sb >> 9) & 1) << 5); R = (st >> 1) * 16 + swz / 64; C = (st & 1) * 32 + (swz % 64) / 2; }
__host__ __device__ __forceinline__ int perm32(int rho) { const int n = rho >> 4, i = rho & 15; return 8 * (i >> 2) + 4 * n + (i & 3); }

struct Unit { int pm, pn; };
struct Gemm { const bf16_t* A; const bf16_t* Bt; int M, N, K; };

struct StaticOrder {
    int nM, nN, nwg, G, c;
    __host__ __device__ void init(int M, int N, int G_, int c_) { nM = M / BM; nN = N / BM; nwg = nM * nN; G = G_; c = c_; }
    __host__ __device__ bool next(int i, Unit& u) const {
        const long L = (long)i * G + c; if (L >= nwg) return false;
        int wgid = (int)L; { const int q = nwg / NXCD, r = nwg % NXCD, xcd = wgid % NXCD, off = wgid / NXCD; wgid = (xcd < r ? xcd * (q + 1) : r * (q + 1) + (xcd - r) * q) + off; }
        const int nig = WGM * nN, gid = wgid / nig, fm = gid * WGM, gsz = (nM - fm) < WGM ? (nM - fm) : WGM;
        u.pm = fm + ((wgid % nig) % gsz); u.pn = (wgid % nig) / gsz; return true;
    }
    __device__ __forceinline__ void a_ready(const Unit&) const {}
    __device__ __forceinline__ void done(const Unit&) const {}
};

__device__ __forceinline__ unsigned cvt_pk_bf16(float lo, float hi) { unsigned r; asm volatile("v_cvt_pk_bf16_f32 %0, %1, %2" : "=v"(r) : "v"(lo), "v"(hi)); return r; }
typedef float f32x2 __attribute__((ext_vector_type(2)));
template <class Epi, class Sched, bool ALIGN_EPI = false, bool SP2 = false>
__device__ __forceinline__ void gemm_phase(PG8_LAS unsigned char* lds, const Gemm g, const Sched& S, const Epi& E) {
    int tid_l = threadIdx.x; asm volatile("" : "+v"(tid_l));
    const int tid = tid_l, wid = __builtin_amdgcn_readfirstlane(tid >> 6), lane = tid & 63, wr = wid >> 2, wc = wid & 3, fr = lane & 15, fq = lane >> 4;
    const int K = g.K, nt = K / BK;
    unsigned voffA[2], voffB[2];
#pragma unroll
    for (int i = 0; i < 2; ++i) { int R, C; stage_rc(tid * 16 + i * 8192, R, C); const int Rb = Epi::PERM ? ((R & ~31) + perm32(R & 31)) : R;
        voffA[i] = (unsigned)(R * K + C) * 2u; voffB[i] = (unsigned)(Rb * K + C) * 2u; }
    const size_t kstep = (size_t)(BK * 2);
    const size_t hstep = (size_t)HALF * K * 2;
    const size_t tstep = 2 * hstep;
    const unsigned ldsw = (unsigned)wid * 1024u;
    const int aoff = lds_byte(wr * 64 + fr, fq * 8), boff = lds_byte(wc * 32 + fr, fq * 8);
#define PG8_SA(b, h) (((b) * 2 + (h)) * HTB)
#define PG8_SB(b, h) ((4 + (b) * 2 + (h)) * HTB)
#define PG8_STAGE(bufoff, gbase, voff) do { _Pragma("unroll") for (int _i = 0; _i < 2; ++_i) \
        __builtin_amdgcn_global_load_lds((const unsigned*)((const char*)(gbase) + (voff)[_i]), (PG8_LAS unsigned*)(lds + (bufoff) + ldsw + _i * 8192), 16, 0, 0); } while (0)
#define PG8_LDA(dst, b, h) do { _Pragma("unroll") for (int m = 0; m < 4; ++m) _Pragma("unroll") for (int k = 0; k < 2; ++k) dst[m][k] = *(const PG8_LAS bf16x8*)(lds + PG8_SA(b, h) + aoff + m * 2048 + k * 1024); } while (0)
#define PG8_LDB(dst, b, h) do { _Pragma("unroll") for (int n = 0; n < 2; ++n) _Pragma("unroll") for (int k = 0; k < 2; ++k) dst[n][k] = *(const PG8_LAS bf16x8*)(lds + PG8_SB(b, h) + boff + n * 2048 + k * 1024); } while (0)
#define PG8_MMA(ai, bj, At, Bt) do { __builtin_amdgcn_s_setprio(1); _Pragma("unroll") for (int m = 0; m < 4; ++m) _Pragma("unroll") for (int n = 0; n < 2; ++n) _Pragma("unroll") for (int k = 0; k < 2; ++k) \
        acc[ai][bj][m][n] = __builtin_amdgcn_mfma_f32_16x16x32_bf16(Bt[n][k], At[m][k], acc[ai][bj][m][n], 0, 0, 0); __builtin_amdgcn_s_setprio(0); } while (0)
#define PG8_WAIT_V(n) asm volatile("s_waitcnt vmcnt(" #n ")" ::: "memory")
#define PG8_WAIT_L(n) asm volatile("s_waitcnt lgkmcnt(" #n ")" ::: "memory")
#define PG8_BAR __builtin_amdgcn_s_barrier()
#define PG8_SCHED __builtin_amdgcn_sched_barrier(0)
    Unit cur, nxt; int ui = 0;
    if (!S.next(0, cur)) return;
    f32x4 acc[2][2][4][2];
#pragma unroll
    for (int a = 0; a < 2; ++a)
#pragma unroll
        for (int b = 0; b < 2; ++b)
#pragma unroll
            for (int m = 0; m < 4; ++m)
#pragma unroll
                for (int n = 0; n < 2; ++n) acc[a][b][m][n] = (f32x4){0.f, 0.f, 0.f, 0.f};
    bf16x8 At[4][2], B0[2][2], B1[2][2];
    const char* cA = (const char*)g.A + (size_t)cur.pm * tstep; const char* cB = (const char*)g.Bt + (size_t)cur.pn * tstep;
    S.a_ready(cur);
    if constexpr (SP2) {
        PG8_STAGE(PG8_SB(0, 0), cB, voffB); PG8_STAGE(PG8_SB(0, 1), cB + hstep, voffB); PG8_STAGE(PG8_SA(0, 0), cA, voffA); PG8_STAGE(PG8_SA(0, 1), cA + hstep, voffA);
        if (wr == 1) PG8_BAR;
        PG8_WAIT_V(2); PG8_BAR;
        PG8_STAGE(PG8_SB(1, 0), cB + kstep, voffB); PG8_STAGE(PG8_SA(1, 0), cA + kstep, voffA); PG8_STAGE(PG8_SB(1, 1), cB + hstep + kstep, voffB);
        PG8_WAIT_V(6); PG8_BAR;
    } else {
        PG8_STAGE(PG8_SB(0, 0), cB, voffB); PG8_STAGE(PG8_SA(0, 0), cA, voffA); PG8_STAGE(PG8_SB(0, 1), cB + hstep, voffB); PG8_STAGE(PG8_SA(0, 1), cA + hstep, voffA);
        if (wr == 1) PG8_BAR;
        PG8_WAIT_V(4); PG8_BAR;
        PG8_STAGE(PG8_SB(1, 0), cB + kstep, voffB); PG8_STAGE(PG8_SA(1, 0), cA + kstep, voffA); PG8_STAGE(PG8_SB(1, 1), cB + hstep + kstep, voffB);
        PG8_WAIT_V(6); PG8_BAR;
    }
    for (;;) {
        const bool has_next = S.next(ui + 1, nxt);
        const char* nA = has_next ? (const char*)g.A + (size_t)nxt.pm * tstep : cA; const char* nB = has_next ? (const char*)g.Bt + (size_t)nxt.pn * tstep : cB;
        for (int t = 0; t < nt; t += 2) {
            const bool last = (t == nt - 2);
            const char* a1 = cA + (size_t)(t + 1) * kstep;
            const char* a2 = last ? nA : cA + (size_t)(t + 2) * kstep; const char* b2 = last ? nB : cB + (size_t)(t + 2) * kstep;
            const char* a3 = a2 + kstep; const char* b3 = b2 + kstep;
            if (last && has_next) S.a_ready(nxt);
            if constexpr (SP2) {
            PG8_LDB(B0, 0, 0); PG8_LDB(B1, 0, 1); PG8_SCHED; PG8_LDA(At, 0, 0); PG8_STAGE(PG8_SA(1, 1), a1 + hstep, voffA);
            PG8_WAIT_V(8); PG8_WAIT_L(0); PG8_BAR; PG8_MMA(0, 0, At, B0); PG8_MMA(0, 1, At, B1); PG8_BAR; PG8_SCHED;
            PG8_LDA(At, 0, 1); PG8_STAGE(PG8_SB(0, 0), b2, voffB); PG8_STAGE(PG8_SB(0, 1), b2 + hstep, voffB); PG8_STAGE(PG8_SA(0, 0), a2, voffA);
            PG8_WAIT_V(8); PG8_WAIT_L(0); PG8_BAR; PG8_MMA(1, 0, At, B0); PG8_MMA(1, 1, At, B1); PG8_BAR; PG8_SCHED;
            PG8_LDB(B0, 1, 0); PG8_LDB(B1, 1, 1); PG8_SCHED; PG8_LDA(At, 1, 0); PG8_STAGE(PG8_SA(0, 1), a2 + hstep, voffA);
            PG8_WAIT_V(8); PG8_WAIT_L(0); PG8_BAR; PG8_MMA(0, 0, At, B0); PG8_MMA(0, 1, At, B1); PG8_BAR; PG8_SCHED;
            PG8_LDA(At, 1, 1); PG8_STAGE(PG8_SB(1, 0), b3, voffB); PG8_STAGE(PG8_SB(1, 1), b3 + hstep, voffB); PG8_STAGE(PG8_SA(1, 0), a3, voffA);
            PG8_WAIT_V(8); PG8_WAIT_L(0); PG8_BAR; PG8_MMA(1, 0, At, B0); PG8_MMA(1, 1, At, B1); PG8_BAR; PG8_SCHED;
            } else {
            PG8_LDB(B0, 0, 0); PG8_SCHED; PG8_LDA(At, 0, 0); PG8_STAGE(PG8_SA(1, 1), a1 + hstep, voffA);
            PG8_WAIT_L(8); PG8_BAR; PG8_WAIT_L(0); PG8_MMA(0, 0, At, B0); PG8_BAR; PG8_SCHED;
            PG8_LDB(B1, 0, 1); PG8_STAGE(PG8_SB(0, 0), b2, voffB);
            PG8_BAR; PG8_WAIT_L(0); PG8_MMA(0, 1, At, B1); PG8_BAR;
            PG8_LDA(At, 0, 1); PG8_STAGE(PG8_SA(0, 0), a2, voffA);
            PG8_BAR; PG8_WAIT_L(0); PG8_MMA(1, 0, At, B0); PG8_BAR; PG8_SCHED;
            PG8_STAGE(PG8_SB(0, 1), b2 + hstep, voffB);
            PG8_WAIT_V(6); PG8_BAR; PG8_MMA(1, 1, At, B1); PG8_BAR;
            PG8_LDB(B0, 1, 0); PG8_SCHED; PG8_LDA(At, 1, 0); PG8_STAGE(PG8_SA(0, 1), a2 + hstep, voffA);
            PG8_WAIT_L(8); PG8_BAR; PG8_WAIT_L(0); PG8_MMA(0, 0, At, B0); PG8_BAR; PG8_SCHED;
            PG8_LDB(B1, 1, 1); PG8_STAGE(PG8_SB(1, 0), b3, voffB);
            PG8_BAR; PG8_WAIT_L(0); PG8_MMA(0, 1, At, B1); PG8_BAR;
            PG8_LDA(At, 1, 1); PG8_STAGE(PG8_SA(1, 0), a3, voffA);
            PG8_BAR; PG8_WAIT_L(0); PG8_MMA(1, 0, At, B0); PG8_BAR; PG8_SCHED;
            PG8_STAGE(PG8_SB(1, 1), b3 + hstep, voffB);
            PG8_WAIT_V(6); PG8_BAR; PG8_MMA(1, 1, At, B1); PG8_BAR;
            }
        }
        if constexpr (ALIGN_EPI) { if (wr == 0) PG8_BAR; }
        if constexpr (!Epi::AFTER_DRAIN) { E(acc, cur, wr, wc, fr, fq); S.done(cur); }
        if (!has_next) break;
#pragma unroll
        for (int a = 0; a < 2; ++a)
#pragma unroll
            for (int b = 0; b < 2; ++b)
#pragma unroll
                for (int m = 0; m < 4; ++m)
#pragma unroll
                    for (int n = 0; n < 2; ++n) acc[a][b][m][n] = (f32x4){0.f, 0.f, 0.f, 0.f};
        cur = nxt; cA = nA; cB = nB; ++ui;
        if constexpr (ALIGN_EPI) { if (wr == 1) PG8_BAR; }
    }
    PG8_WAIT_V(0);
    if constexpr (!ALIGN_EPI) { if (wr == 0) PG8_BAR; }
    PG8_BAR;
    if constexpr (Epi::AFTER_DRAIN) { E.fused(acc, cur, wr, wc, fr, fq, lds, wid, lane); S.done(cur); }
#undef PG8_SA
#undef PG8_SB
#undef PG8_STAGE
#undef PG8_LDA
#undef PG8_LDB
#undef PG8_MMA
#undef PG8_WAIT_V
#undef PG8_WAIT_L
#undef PG8_BAR
#undef PG8_SCHED
}
}
namespace pg8 {
typedef unsigned u32x2 __attribute__((ext_vector_type(2)));
__device__ __forceinline__ float bf2f(unsigned b16) { return __uint_as_float(b16 << 16); }
__device__ __forceinline__ float bflo(unsigned w) { return __uint_as_float(w << 16); }
__device__ __forceinline__ float bfhi(unsigned w) { return __uint_as_float(w & 0xffff0000u); }
__device__ __forceinline__ float h2f(unsigned h16) { return (float)__builtin_bit_cast(_Float16, (unsigned short)h16); }
__device__ __forceinline__ float rstd_of(const float* ssq, int row) { const f32x4* p = (const f32x4*)(ssq + (size_t)row * 16); const f32x4 a = p[0], b = p[1], c = p[2], d = p[3];
    const float s = ((a[0] + a[1]) + (a[2] + a[3])) + ((b[0] + b[1]) + (b[2] + b[3])) + ((c[0] + c[1]) + (c[2] + c[3])) + ((d[0] + d[1]) + (d[2] + d[3])); return 1.0f / sqrtf(s * (1.0f / 1024.0f) + 1e-6f); }
__device__ __forceinline__ float silu_f(float x) { return x * __builtin_amdgcn_rcpf(1.0f + __builtin_amdgcn_exp2f(-1.4426950408889634f * x)); }
__device__ __forceinline__ u32x4 pack8(const f32x4& a, const f32x4& b) { u32x4 w; w.x = cvt_pk_bf16(a[0], a[1]); w.y = cvt_pk_bf16(a[2], a[3]); w.z = cvt_pk_bf16(b[0], b[1]); w.w = cvt_pk_bf16(b[2], b[3]); return w; }

struct EpiRetQKV {
    static constexpr bool PERM = true, AFTER_DRAIN = false;
    bf16_t *q, *k, *v; const float* ssq; const unsigned* rope;
    __device__ __forceinline__ void operator()(const f32x4 (&acc)[2][2][4][2], const Unit& u, int wr, int wc, int fr, int fq) const {
        const int t = u.pn; bf16_t* base; int ldc, colt;
        if (t < 4) { base = q; ldc = 1024; colt = t * 256; } else if (t < 8) { base = k; ldc = 1024; colt = (t - 4) * 256; } else { base = v; ldc = 2048; colt = (t - 8) * 256; }
        const bool rp = t < 8;
        const float lg2 = __builtin_amdgcn_logf(1.0f - __builtin_amdgcn_exp2f(-5.0f - (float)(t & 3)));
        const int row0 = u.pm * BM + wr * 64 + fr, d0 = wc * 32 + 8 * fq, col0 = colt + d0;
#pragma unroll
        for (int ai = 0; ai < 2; ++ai)
#pragma unroll
            for (int m = 0; m < 4; ++m) {
                const int row = row0 + ai * HALF + m * 16; const float rs = rstd_of(ssq, row);
                f32x4 v0[2], v1[2];
#pragma unroll
                for (int n = 0; n < 2; ++n) { v0[n] = acc[ai][0][m][n] * rs; v1[n] = acc[ai][1][m][n] * rs; }
                if (rp) {
                    const float dsc = __builtin_amdgcn_exp2f((t < 4 ? lg2 : -lg2) * (float)((row & 255) + 1));
#pragma unroll
                    for (int n = 0; n < 2; ++n) { const u32x4 cs = *(const u32x4*)(rope + (size_t)row * 128 + d0 + 4 * n);
#pragma unroll
                        for (int e = 0; e < 4; ++e) { const float c = h2f(cs[e] & 0xffffu) * dsc, s = h2f(cs[e] >> 16) * dsc, a = v0[n][e], b = v1[n][e]; v0[n][e] = a * c - b * s; v1[n][e] = b * c + a * s; } }
                }
                bf16_t* rowp = base + (size_t)row * ldc + col0;
                *(u32x4*)(rowp) = pack8(v0[0], v0[1]); *(u32x4*)(rowp + HALF) = pack8(v1[0], v1[1]);
            }
    }
};

struct EpiGate {
    static constexpr bool PERM = true, AFTER_DRAIN = false;
    bf16_t* O; const float* ssq;
    __device__ __forceinline__ void operator()(const f32x4 (&acc)[2][2][4][2], const Unit& u, int wr, int wc, int fr, int fq) const {
        const int row0 = u.pm * BM + wr * 64 + fr, col0 = u.pn * BM + wc * 32 + 8 * fq;
#pragma unroll
        for (int ai = 0; ai < 2; ++ai)
#pragma unroll
            for (int m = 0; m < 4; ++m) {
                const int row = row0 + ai * HALF + m * 16; const float rs = rstd_of(ssq, row);
#pragma unroll
                for (int bj = 0; bj < 2; ++bj) { bf16_t* p = O + (size_t)row * 2048 + col0 + bj * HALF; const u32x4 ov = *(const u32x4*)p; f32x4 r[2];
#pragma unroll
                    for (int n = 0; n < 2; ++n)
#pragma unroll
                        for (int e = 0; e < 4; ++e) { const unsigned w = ov[2 * n + (e >> 1)]; const float o = (e & 1) ? bfhi(w) : bflo(w); r[n][e] = o * silu_f(acc[ai][bj][m][n][e] * rs); }
                    *(u32x4*)p = pack8(r[0], r[1]); }
            }
    }
};

struct EpiSwiGLU {
    static constexpr bool PERM = true, AFTER_DRAIN = false;
    bf16_t* Hb; const float* ssq;
    __device__ __forceinline__ void operator()(const f32x4 (&acc)[2][2][4][2], const Unit& u, int wr, int wc, int fr, int fq) const {
        const int row0 = u.pm * BM + wr * 64 + fr, col0 = u.pn * HALF + wc * 32 + 8 * fq;
#pragma unroll
        for (int ai = 0; ai < 2; ++ai)
#pragma unroll
            for (int m = 0; m < 4; ++m) {
                const int row = row0 + ai * HALF + m * 16; const float rs = rstd_of(ssq, row); f32x4 r[2];
#pragma unroll
                for (int n = 0; n < 2; ++n)
#pragma unroll
                    for (int e = 0; e < 4; ++e) r[n][e] = silu_f(acc[ai][0][m][n][e] * rs) * (acc[ai][1][m][n][e] * rs);
                *(u32x4*)(Hb + (size_t)row * 2816 + col0) = pack8(r[0], r[1]);
            }
    }
};

struct EpiLruIn {
    static constexpr bool PERM = true, AFTER_DRAIN = false;
    bf16_t *gate, *uraw; const float* ssq;
    __device__ __forceinline__ void operator()(const f32x4 (&acc)[2][2][4][2], const Unit& u, int wr, int wc, int fr, int fq) const {
        const int t = u.pn; bf16_t* base = t < 6 ? gate : uraw; const int colt = (t < 6 ? t : t - 6) * 256;
        const int row0 = u.pm * BM + wr * 64 + fr, col0 = colt + wc * 32 + 8 * fq;
#pragma unroll
        for (int ai = 0; ai < 2; ++ai)
#pragma unroll
            for (int m = 0; m < 4; ++m) {
                const int row = row0 + ai * HALF + m * 16; const float rs = rstd_of(ssq, row);
                bf16_t* rowp = base + (size_t)row * 1536 + col0;
#pragma unroll
                for (int bj = 0; bj < 2; ++bj) *(u32x4*)(rowp + bj * HALF) = pack8(acc[ai][bj][m][0] * rs, acc[ai][bj][m][1] * rs);
            }
    }
};

struct EpiSwaQKV {
    static constexpr bool PERM = true, AFTER_DRAIN = false;
    bf16_t *q, *k, *v; const float* ssq; const unsigned* rope; const float* bias;
    __device__ __forceinline__ void operator()(const f32x4 (&acc)[2][2][4][2], const Unit& u, int wr, int wc, int fr, int fq) const {
        const int t = u.pn; bf16_t* base; int ldc, colt; float sc = 1.0f;
        if (t < 4) { base = q; ldc = 1024; colt = t * 256; sc = 0.125f; } else if (t == 4) { base = k; ldc = 256; colt = 0; } else { base = v; ldc = 256; colt = 0; }
        const bool rp = t < 5;
        const int row0 = u.pm * BM + wr * 64 + fr, d0 = 8 * fq, ncol0 = 64 * wc + 8 * fq;
#pragma unroll
        for (int ai = 0; ai < 2; ++ai)
#pragma unroll
            for (int m = 0; m < 4; ++m) {
                asm volatile("" ::: "memory");
                const int row = row0 + ai * HALF + m * 16; const float rs = rstd_of(ssq, row);
                f32x4 v0[2], v1[2];
#pragma unroll
                for (int n = 0; n < 2; ++n) { v0[n] = acc[ai][0][m][n] * rs + *(const f32x4*)(bias + t * 256 + ncol0 + 4 * n); v1[n] = acc[ai][1][m][n] * rs + *(const f32x4*)(bias + t * 256 + ncol0 + 32 + 4 * n); }
                if (rp) {
#pragma unroll
                    for (int n = 0; n < 2; ++n) { const u32x4 cs = *(const u32x4*)(rope + (size_t)row * 32 + d0 + 4 * n);
#pragma unroll
                        for (int e = 0; e < 4; ++e) { const float c = h2f(cs[e] & 0xffffu), s = h2f(cs[e] >> 16), a = v0[n][e], b = v1[n][e]; v0[n][e] = (a * c - b * s) * sc; v1[n][e] = (b * c + a * s) * sc; } }
                }
                bf16_t* rowp = base + (size_t)row * ldc + colt + ncol0;
                *(u32x4*)(rowp) = pack8(v0[0], v0[1]); *(u32x4*)(rowp + 32) = pack8(v1[0], v1[1]);
            }
    }
};

struct EpiRes {
    static constexpr bool PERM = false, AFTER_DRAIN = false;
    const float* base; float* out; bf16_t* xn; float* ssq; const float* bias;
    __device__ __forceinline__ void operator()(const f32x4 (&acc)[2][2][4][2], const Unit& u, int wr, int wc, int fr, int fq) const {
        const int col0 = u.pn * BM + wc * 32 + 4 * fq;
        f32x4 bv[2][2];
#pragma unroll
        for (int bj = 0; bj < 2; ++bj)
#pragma unroll
            for (int n = 0; n < 2; ++n) bv[bj][n] = bias ? *(const f32x4*)(bias + col0 + bj * HALF + n * 16) : (f32x4){0.f, 0.f, 0.f, 0.f};
#pragma unroll
        for (int ai = 0; ai < 2; ++ai)
#pragma unroll
            for (int m = 0; m < 4; ++m) {
                const int row = u.pm * BM + ai * HALF + wr * 64 + m * 16 + fr; const size_t off = (size_t)row * 1024 + col0; float s = 0.f;
#pragma unroll
                for (int bj = 0; bj < 2; ++bj)
#pragma unroll
                    for (int n = 0; n < 2; ++n) { const f32x4 b = *(const f32x4*)(base + off + bj * HALF + n * 16); const f32x4 x = acc[ai][bj][m][n] + b + bv[bj][n];
                        *(f32x4*)(out + off + bj * HALF + n * 16) = x; u32x2 w; w.x = cvt_pk_bf16(x[0], x[1]); w.y = cvt_pk_bf16(x[2], x[3]); *(u32x2*)(xn + off + bj * HALF + n * 16) = w;
                        s += (x[0] * x[0] + x[1] * x[1]) + (x[2] * x[2] + x[3] * x[3]); }
                s += __shfl_xor(s, 16); s += __shfl_xor(s, 32);
                if (fq == 0) ssq[(size_t)row * 16 + u.pn * 4 + wc] = s;
            }
    }
};
}
#define GAS __attribute__((address_space(1)))
#define LAS __attribute__((address_space(3)))
typedef unsigned short bf16;
typedef unsigned v4u __attribute__((ext_vector_type(4)));
typedef float f32x4 __attribute__((ext_vector_type(4)));
typedef short bf16x8 __attribute__((ext_vector_type(8)));
typedef GAS unsigned gu32;
typedef GAS unsigned long long gu64;
#define RLX_AGENT __ATOMIC_RELAXED, __HIP_MEMORY_SCOPE_AGENT
#define LDS_WAIT() asm volatile("s_waitcnt lgkmcnt(0)" ::: "memory")
#define VM_WAIT() asm volatile("s_waitcnt vmcnt(0)" ::: "memory")
__device__ __forceinline__ unsigned long long rt() { return __builtin_amdgcn_s_memrealtime(); }
__device__ __forceinline__ unsigned f2bf(float f) { unsigned u = __builtin_bit_cast(unsigned, f); return (u + 0x7fffu + ((u >> 16) & 1u)) >> 16; }
__device__ __forceinline__ unsigned pk2(float lo, float hi) { return f2bf(lo) | (f2bf(hi) << 16); }

#define XB_TMO      128
#define XB_XCNT(j)  (256  + 64 * (j))
#define XB_XSUB(j)  (1280 + 64 * (j))
#define XB_XGEN(j)  (2304 + 64 * (j))
#define XB_TOP      3328
#define XB_TOPGEN   3392
#define XCD_BAR_WORDS 3456
#define XB_SPIN_CAP (1u << 18)

__device__ __forceinline__ unsigned xb_ld(unsigned* p)              { return __hip_atomic_load(p, __ATOMIC_RELAXED, __HIP_MEMORY_SCOPE_AGENT); }
__device__ __forceinline__ unsigned xb_add(unsigned* p, unsigned v) { return __hip_atomic_fetch_add(p, v, __ATOMIC_RELAXED, __HIP_MEMORY_SCOPE_AGENT); }
__device__ __forceinline__ unsigned xb_xcc_id() { return (unsigned)__builtin_amdgcn_s_getreg((3 << 11) | 20) & 0xFu; }
#define XB_SPIN(cond, bar) do { unsigned _sp = 0; while (cond) { __builtin_amdgcn_s_sleep(1); \
    if ((++_sp & 255u) == 0u) { if (xb_ld(&(bar)[XB_TMO])) break; if (_sp > XB_SPIN_CAP) { atomicAdd(&(bar)[XB_TMO], 1u); break; } } } } while (0)

struct XcdBarrier {
    unsigned* bar; unsigned x;
    volatile LAS unsigned* st;
};

__device__ __forceinline__ XcdBarrier xcd_barrier_post(unsigned* bar, volatile LAS unsigned* st) {
    XcdBarrier b; b.bar = bar; b.x = xb_xcc_id(); b.st = st;
    if (threadIdx.x == 0) (void)xb_add(&bar[XB_XCNT(b.x)], 1u);
    return b;
}
__device__ __forceinline__ void xcd_barrier_complete(unsigned* bar, unsigned x, unsigned& nloc, unsigned& nx) {
    const unsigned G = gridDim.x * gridDim.y * gridDim.z;
    unsigned sum, cnt, mine, sp = 0u;
    for (;;) {
        sum = 0u; cnt = 0u; mine = 0u;
#pragma unroll
        for (unsigned j = 0; j < 16; ++j) { const unsigned c = xb_ld(&bar[XB_XCNT(j)]); sum += c; cnt += (c > 0u) ? 1u : 0u; mine = (j == x) ? c : mine; }
        if (sum == G) break;
        __builtin_amdgcn_s_sleep(1);
        if ((++sp & 255u) == 0u) { if (xb_ld(&bar[XB_TMO])) break; if (sp > XB_SPIN_CAP) { atomicAdd(&bar[XB_TMO], 1u); break; } }
    }
    nloc = mine > 0u ? mine : 1u; nx = cnt > 0u ? cnt : 1u;
}

__device__ __forceinline__ void xcd_barrier(const XcdBarrier& b) {
    asm volatile("s_waitcnt vmcnt(0)" ::: "memory");
    __syncthreads();
    if (threadIdx.x == 0) {
        unsigned* bar = b.bar;
        __builtin_amdgcn_s_waitcnt(0);
        unsigned nloc = b.st[0], nx = b.st[1];
        if (nloc == 0u) { xcd_barrier_complete(bar, b.x, nloc, nx); b.st[0] = nloc; b.st[1] = nx; }
        const unsigned old = xb_add(&bar[XB_XSUB(b.x)], 1u);
        const unsigned gen = old / nloc;
        if (old + 1u == (gen + 1u) * nloc) {
            __builtin_amdgcn_fence(__ATOMIC_RELEASE, "agent");
            asm volatile("s_waitcnt vmcnt(0)" ::: "memory");
            const unsigned og = xb_add(&bar[XB_TOP], 1u);
            const unsigned tg = og / nx;
            if (og + 1u == (tg + 1u) * nx) xb_add(&bar[XB_TOPGEN], 1u);
            else XB_SPIN(xb_ld(&bar[XB_TOPGEN]) == tg, bar);
            __builtin_amdgcn_fence(__ATOMIC_ACQUIRE, "agent");
            xb_add(&bar[XB_XGEN(b.x)], 1u);
            asm volatile("s_waitcnt vmcnt(0)" ::: "memory");
        } else {
            XB_SPIN(xb_ld(&bar[XB_XGEN(b.x)]) == gen, bar);
            __builtin_amdgcn_fence(__ATOMIC_ACQUIRE, "agent");
            asm volatile("s_waitcnt vmcnt(0)" ::: "memory");
        }
    }
    __syncthreads();
}
constexpr int NWAVES = 8;
constexpr int BATCH = 8, SEQ = 2048, DM = 1024, M = BATCH * SEQ, DEPTH = 4;
constexpr int RET_H = 4, RET_DK = 256, RET_DV = 512, RET_C = 128;
constexpr int LRU_W = 1536, LRU_NB = 8, LRU_BW = 192;
constexpr int SWA_DH = 64, SWA_HQ = 16, SWA_HKV = 4, SWA_WIN = 128;
constexpr int FFN_H = 2816;
constexpr int N_IN = 23;
enum In { I_X = 0, I_POS, I_MIXN, I_FFNN, I_FINN, I_RET_WIN, I_RET_WOUT, I_LRU_WIN, I_LRU_CW, I_LRU_CB, I_LRU_WR, I_LRU_BR, I_LRU_WI, I_LRU_BI, I_LRU_LAM, I_LRU_WOUT,
          I_SWA_WQKV, I_SWA_BQKV, I_SWA_SINK, I_SWA_WOUT, I_SWA_BOUT, I_FFN_WGU, I_FFN_WDN };

constexpr size_t MiB = 1u << 20;
constexpr size_t WS_CTL = 0, CTL_ZERO_BYTES = 64 * 1024;
constexpr size_t WS_SSQ = 1 * MiB;
constexpr size_t WS_W = 3 * MiB;
constexpr size_t WO_RETIN = 0, WO_RETOUT = 12582912, WO_LRUIN = 16777216, WO_LRUOUT = 19922944, WO_SWAQKV = 21495808, WO_SWAOUT = 23068672, WO_FFNGU = 24117248, WO_FFNDN = 47185920, WO_END = 58720256;
constexpr size_t WS_ROPEA = 115 * MiB, WS_ROPEB = 123 * MiB, WS_XN = 125 * MiB, WS_ACT = 157 * MiB, WS_END = 349 * MiB;
static_assert(WS_W + WO_END * 2 <= WS_ROPEA, "weights fit");
constexpr size_t A_RQ = 0, A_RK = 32 * MiB, A_RV = 64 * MiB, A_RO = 128 * MiB;
constexpr size_t A_H = 0;
constexpr size_t A_LG = 0, A_LU = 48 * MiB, A_LUC = 96 * MiB, A_LY = 144 * MiB;
constexpr size_t A_SQ = 0, A_SK = 32 * MiB, A_SV = 40 * MiB, A_SO = 48 * MiB;
constexpr int CW_BAR = 1024;

constexpr int RING_BYTES = 131072;
constexpr int LDS_BYTES = 163840;
constexpr int LDSCTL_OFF = LDS_BYTES - 1024, MISC_OFF = LDSCTL_OFF + 320;
constexpr int LDS_AUX_OFF = RING_BYTES + 1024;

struct Args { const void* in[N_IN]; float* out; unsigned char* ws; int ph_lo, ph_hi, li, pad; };
typedef const __attribute__((address_space(4))) Args* CArgs;
struct Frame {
    LAS unsigned char* lds;
    volatile LAS unsigned* MISC;
    gu32* ctl;
    int tid, lane, wave, G, bx;
    CArgs ap;
    unsigned char* ws;
};
__device__ __forceinline__ const float* inF(const Frame& F, int i) { return (const float*)F.ap->in[i]; }
__device__ __forceinline__ bf16* wsW(const Frame& F, size_t eoff) { return (bf16*)(F.ws + WS_W) + eoff; }
__device__ __forceinline__ bf16* wsA(const Frame& F, size_t boff) { return (bf16*)(F.ws + WS_ACT + boff); }
__device__ __forceinline__ float* wsSSQ(const Frame& F, int idx) { return (float*)(F.ws + WS_SSQ) + (size_t)(idx & 1) * M * 16; }
__device__ __forceinline__ float bf2f(unsigned b16) { return __uint_as_float(b16 << 16); }
__device__ __forceinline__ float bflo(unsigned w) { return __uint_as_float(w << 16); }
__device__ __forceinline__ float bfhi(unsigned w) { return __uint_as_float(w & 0xffff0000u); }

__device__ __forceinline__ float wave_sum(float v) {
#pragma unroll
    for (int o = 1; o < 64; o <<= 1) v += __shfl_xor(v, o);
    return v;
}
__device__ __forceinline__ float wave_max(float v) {
#pragma unroll
    for (int o = 1; o < 64; o <<= 1) v = fmaxf(v, __shfl_xor(v, o));
    return v;
}

struct Job { const float* W; bf16* WT; const float* gain; int K, Npitch, Nd, map; };
constexpr int NJOBS = 16;
__host__ __device__ constexpr int job_items(int j) {
    return j < 2 ? (1024 / 64) * (6144 / 32) : j < 4 ? (2048 / 64) * (1024 / 32) : j == 4 ? (1024 / 64) * (3072 / 32) : j == 5 ? (1536 / 64) * (1024 / 32) : j == 6 ? (1024 / 64) * (1536 / 32)
         : j == 7 ? (1024 / 64) * (1024 / 32) : j < 12 ? (1024 / 64) * (5632 / 32) : (2816 / 64) * (1024 / 32);
}
__host__ __device__ constexpr int job_items_total() { int s = 0; for (int j = 0; j < NJOBS; ++j) s += job_items(j); return s; }
__device__ __forceinline__ void get_job(const Frame& F, int j, Job& J) {
    if (j < 2)       { J.W = inF(F, I_RET_WIN) + (size_t)j * 1024 * 6144; J.WT = wsW(F, WO_RETIN + (size_t)j * 6144 * 1024); J.gain = inF(F, I_MIXN) + (j == 0 ? 0 : 3) * 1024; J.K = 1024; J.Npitch = 6144; J.Nd = 6144; J.map = 1; }
    else if (j < 4)  { const int q = j - 2; J.W = inF(F, I_RET_WOUT) + (size_t)q * 2048 * 1024; J.WT = wsW(F, WO_RETOUT + (size_t)q * 1024 * 2048); J.gain = nullptr; J.K = 2048; J.Npitch = 1024; J.Nd = 1024; J.map = 0; }
    else if (j == 4) { J.W = inF(F, I_LRU_WIN); J.WT = wsW(F, WO_LRUIN); J.gain = inF(F, I_MIXN) + 1 * 1024; J.K = 1024; J.Npitch = 3072; J.Nd = 3072; J.map = 0; }
    else if (j == 5) { J.W = inF(F, I_LRU_WOUT); J.WT = wsW(F, WO_LRUOUT); J.gain = nullptr; J.K = 1536; J.Npitch = 1024; J.Nd = 1024; J.map = 0; }
    else if (j == 6) { J.W = inF(F, I_SWA_WQKV); J.WT = wsW(F, WO_SWAQKV); J.gain = inF(F, I_MIXN) + 2 * 1024; J.K = 1024; J.Npitch = 1536; J.Nd = 1536; J.map = 3; }
    else if (j == 7) { J.W = inF(F, I_SWA_WOUT); J.WT = wsW(F, WO_SWAOUT); J.gain = nullptr; J.K = 1024; J.Npitch = 1024; J.Nd = 1024; J.map = 0; }
    else if (j < 12) { const int l = j - 8; J.W = inF(F, I_FFN_WGU) + (size_t)l * 1024 * 5632; J.WT = wsW(F, WO_FFNGU + (size_t)l * 5632 * 1024); J.gain = inF(F, I_FFNN) + l * 1024; J.K = 1024; J.Npitch = 5632; J.Nd = 5632; J.map = 2; }
    else             { const int l = j - 12; J.W = inF(F, I_FFN_WDN) + (size_t)l * 2816 * 1024; J.WT = wsW(F, WO_FFNDN + (size_t)l * 1024 * 2816); J.gain = nullptr; J.K = 2816; J.Npitch = 1024; J.Nd = 1024; J.map = 0; }
}
__device__ __forceinline__ int src_col(int map, int nd) {
    if (map == 2) { const int pn = nd >> 8, p = nd & 255; return p < 128 ? 128 * pn + p : FFN_H + 128 * pn + (p - 128); }
    if (map == 3) { const int t = nd >> 8, p = nd & 255; return 256 * t + 64 * ((p & 127) >> 5) + 32 * (p >> 7) + (p & 31); }
    return nd;
}
__device__ __forceinline__ void p0_transpose_item(const Job& J, LAS float* scr, int item, int lane) {
    const int nblk = J.Nd / 32, kb = item / nblk, nb = item % nblk, k0 = 64 * kb, nd0 = 32 * nb, ns0 = src_col(J.map, nd0);
    const float cs = (J.map == 1 && nd0 >= 1024 && nd0 < 2048) ? 0.0625f : 1.0f;
#pragma unroll 8
    for (int i = 0; i < 32; ++i) { const int kk = 2 * i + (lane >> 5); const float g = J.gain ? J.gain[k0 + kk] * cs : cs; scr[kk * 33 + (lane & 31)] = J.W[(size_t)(k0 + kk) * J.Npitch + ns0 + (lane & 31)] * g; }
    LDS_WAIT(); asm volatile("" ::: "memory");
    const int c = lane & 7;
#pragma unroll
    for (int j = 0; j < 4; ++j) { const int n = (lane >> 3) + 8 * j; const LAS float* s = scr + (8 * c) * 33 + n;
        v4u o; o.x = pk2(s[0 * 33], s[1 * 33]); o.y = pk2(s[2 * 33], s[3 * 33]); o.z = pk2(s[4 * 33], s[5 * 33]); o.w = pk2(s[6 * 33], s[7 * 33]);
        *(GAS v4u*)(J.WT + (size_t)(nd0 + n) * J.K + k0 + 8 * c) = o; }
    LDS_WAIT(); asm volatile("" ::: "memory");
}
__device__ __forceinline__ unsigned pack_cs(float ang) {
    const float n = rintf(ang * 0.15915494309189535f);
    float r = fmaf(-n, 6.28125f, ang); r = fmaf(-n, 1.9353071795864769e-3f, r);
    const float rev = r * 0.15915494309189535f;
    const float c = __builtin_amdgcn_cosf(rev), s = __builtin_amdgcn_sinf(rev);
    const unsigned short cb = __builtin_bit_cast(unsigned short, (_Float16)c), sb = __builtin_bit_cast(unsigned short, (_Float16)s);
    return (unsigned)cb | ((unsigned)sb << 16);
}
__device__ __forceinline__ void p0_prologue(Frame& F) {
    LAS float* scr = (LAS float*)(F.lds + F.wave * 16384);
    const int gw = F.bx * NWAVES + F.wave, NGW = F.G * NWAVES;
    constexpr int NITEMS = job_items_total();
    for (int it = gw; it < NITEMS; it += NGW) {
        int r = it, j = 0;
        for (; j < NJOBS - 1; ++j) { const int n = job_items(j); if (r < n) break; r -= n; }
        Job J; get_job(F, j, J);
        p0_transpose_item(J, scr, r, F.lane);
    }
    const int* pos = (const int*)F.ap->in[I_POS];
    unsigned* ropeA = (unsigned*)(F.ws + WS_ROPEA); unsigned* ropeB = (unsigned*)(F.ws + WS_ROPEB);
    const float* x = inF(F, I_X); bf16* xn = (bf16*)(F.ws + WS_XN); float* ssq0 = wsSSQ(F, 0);
    const float ifA0 = powf(10000.0f, -((float)F.lane * 2.0f / 256.0f)), ifA1 = powf(10000.0f, -((float)(F.lane + 64) * 2.0f / 256.0f)), ifB = powf(10000.0f, -((float)(F.lane & 31) * 2.0f / 64.0f));
    for (int m = gw; m < M; m += NGW) {
        const float p = (float)pos[m];
        ropeA[(size_t)m * 128 + F.lane] = pack_cs(p * ifA0); ropeA[(size_t)m * 128 + 64 + F.lane] = pack_cs(p * ifA1);
        if (F.lane < 32) ropeB[(size_t)m * 32 + F.lane] = pack_cs(p * ifB);
        const GAS f32x4* xr = (const GAS f32x4*)(x + (size_t)m * DM) + F.lane; f32x4 v[4]; float s = 0.f;
#pragma unroll
        for (int j = 0; j < 4; ++j) { v[j] = xr[64 * j]; s += (v[j].x * v[j].x + v[j].y * v[j].y) + (v[j].z * v[j].z + v[j].w * v[j].w); }
        s = wave_sum(s); if (F.lane < 16) ssq0[(size_t)m * 16 + F.lane] = F.lane == 0 ? s : 0.f;
        GAS unsigned long long* o8 = (GAS unsigned long long*)(xn + (size_t)m * DM) + F.lane;
#pragma unroll
        for (int j = 0; j < 4; ++j) o8[64 * j] = (unsigned long long)pk2(v[j].x, v[j].y) | ((unsigned long long)pk2(v[j].z, v[j].w) << 32);
    }
}
__device__ __forceinline__ void final_norm(Frame& F) {
    const int gw = F.bx * NWAVES + F.wave, NGW = F.G * NWAVES; const float* g = inF(F, I_FINN); float* out = F.ap->out;
    f32x4 gv[4];
#pragma unroll
    for (int j = 0; j < 4; ++j) gv[j] = ((const f32x4*)g)[F.lane + 64 * j];
    for (int m = gw; m < M; m += NGW) {
        GAS f32x4* xr = (GAS f32x4*)(out + (size_t)m * DM) + F.lane; f32x4 v[4]; float s = 0.f;
#pragma unroll
        for (int j = 0; j < 4; ++j) { v[j] = xr[64 * j]; s += (v[j].x * v[j].x + v[j].y * v[j].y) + (v[j].z * v[j].z + v[j].w * v[j].w); }
        const float rs = 1.0f / sqrtf(wave_sum(s) * (1.0f / DM) + 1e-6f);
#pragma unroll
        for (int j = 0; j < 4; ++j) xr[64 * j] = v[j] * rs * gv[j];
    }
}

__device__ __forceinline__ void ret_core_naive(Frame& F) {
    const int w = F.bx; if (w >= 256) return;
    const int b = w >> 5, h = (w >> 3) & 3, vs = w & 7, tid = F.tid;
    LAS float* S = (LAS float*)F.lds; LAS float* P = S + 256 * 64; LAS float* kdec = (LAS float*)(F.lds + LDS_AUX_OFF);
    const float lg = log1pf(-exp2f(-5.0f - (float)h));
    for (int i = tid; i < 256 * 64; i += 512) S[i] = 0.f;
    if (tid < 128) kdec[tid] = expf((float)(127 - tid) * lg);
    const float cdec = expf(128.0f * lg);
    __syncthreads();
    const bf16* Q = wsA(F, A_RQ); const bf16* K = wsA(F, A_RK); const bf16* V = wsA(F, A_RV); bf16* O = wsA(F, A_RO);
    for (int c = 0; c < SEQ / RET_C; ++c) {
        const size_t r0 = (size_t)b * SEQ + (size_t)c * RET_C;
        const bf16* qc = Q + r0 * 1024 + h * 256; const bf16* kc = K + r0 * 1024 + h * 256; const bf16* vc = V + r0 * 2048 + h * 512 + vs * 64; bf16* oc = O + r0 * 2048 + h * 512 + vs * 64;
        for (int idx = tid; idx < 128 * 128; idx += 512) {
            const int i = idx >> 7, j = idx & 127; float s = 0.f;
            if (j <= i) {
                const v4u* qp = (const v4u*)(qc + (size_t)i * 1024); const v4u* kp = (const v4u*)(kc + (size_t)j * 1024);
                for (int d8 = 0; d8 < 32; ++d8) { const v4u a = qp[d8], bb = kp[d8];
                    s += bflo(a.x) * bflo(bb.x) + bfhi(a.x) * bfhi(bb.x) + bflo(a.y) * bflo(bb.y) + bfhi(a.y) * bfhi(bb.y) + bflo(a.z) * bflo(bb.z) + bfhi(a.z) * bfhi(bb.z) + bflo(a.w) * bflo(bb.w) + bfhi(a.w) * bfhi(bb.w); }
                s *= expf((float)(i - j) * lg);
            }
            P[idx] = s;
        }
        __syncthreads();
        for (int idx = tid; idx < 128 * 64; idx += 512) {
            const int i = idx >> 6, vv = idx & 63; float inner = 0.f, cross = 0.f;
#pragma unroll 8
            for (int j = 0; j <= i; ++j) inner += P[i * 128 + j] * bf2f(vc[(size_t)j * 2048 + vv]);
#pragma unroll 8
            for (int d = 0; d < 256; ++d) cross += bf2f(qc[(size_t)i * 1024 + d]) * S[d * 64 + vv];
            oc[(size_t)i * 2048 + vv] = (bf16)f2bf(inner + cross * expf((float)(i + 1) * lg));
        }
        __syncthreads();
        for (int idx = tid; idx < 256 * 64; idx += 512) {
            const int d = idx >> 6, vv = idx & 63; float a = 0.f;
#pragma unroll 8
            for (int j = 0; j < 128; ++j) a += bf2f(kc[(size_t)j * 1024 + d]) * kdec[j] * bf2f(vc[(size_t)j * 2048 + vv]);
            S[idx] = S[idx] * cdec + a;
        }
        __syncthreads();
    }
}
__device__ __forceinline__ void ret_norm_naive(Frame& F) {
    const int gw = F.bx * NWAVES + F.wave, NGW = F.G * NWAVES; bf16* V = wsA(F, A_RO);
    for (int it = gw; it < M * RET_H; it += NGW) {
        GAS v4u* p = (GAS v4u*)(V + (size_t)it * 512) + F.lane; const v4u a = *p;
        float f[8] = {bflo(a.x), bfhi(a.x), bflo(a.y), bfhi(a.y), bflo(a.z), bfhi(a.z), bflo(a.w), bfhi(a.w)}; float s = 0.f;
#pragma unroll
        for (int e = 0; e < 8; ++e) s += f[e] * f[e];
        const float rs = 1.0f / sqrtf(wave_sum(s) * (1.0f / 512.0f) + 1e-6f);
        v4u o; o.x = pk2(f[0] * rs, f[1] * rs); o.y = pk2(f[2] * rs, f[3] * rs); o.z = pk2(f[4] * rs, f[5] * rs); o.w = pk2(f[6] * rs, f[7] * rs); *p = o;
    }
}
__device__ __forceinline__ void lru_conv_naive(Frame& F) {
    const bf16* UR = wsA(F, A_LU); bf16* UC = wsA(F, A_LUC); const float* cw = inF(F, I_LRU_CW); const float* cb = inF(F, I_LRU_CB);
    const int gt = F.bx * 512 + F.tid, NGT = F.G * 512;
    for (int it = gt; it < M * (LRU_W / 8); it += NGT) {
        const int row = it / (LRU_W / 8), ch0 = (it % (LRU_W / 8)) * 8, t = row & (SEQ - 1); float a[8];
#pragma unroll
        for (int e = 0; e < 8; ++e) a[e] = cb[ch0 + e];
#pragma unroll
        for (int w = 0; w < 4; ++w) { if (t - 3 + w >= 0) { const v4u u = *(const v4u*)(UR + (size_t)(row - 3 + w) * LRU_W + ch0); const float* c = cw + w * LRU_W + ch0;
            a[0] += c[0] * bflo(u.x); a[1] += c[1] * bfhi(u.x); a[2] += c[2] * bflo(u.y); a[3] += c[3] * bfhi(u.y); a[4] += c[4] * bflo(u.z); a[5] += c[5] * bfhi(u.z); a[6] += c[6] * bflo(u.w); a[7] += c[7] * bfhi(u.w); } }
        v4u o; o.x = pk2(a[0], a[1]); o.y = pk2(a[2], a[3]); o.z = pk2(a[4], a[5]); o.w = pk2(a[6], a[7]); *(v4u*)(UC + (size_t)row * LRU_W + ch0) = o;
    }
}
__device__ __forceinline__ float gelu_tanh(float x) { const float u = 0.7978845608028654f * (x + 0.044715f * x * x * x); const float e = __expf(2.0f * u); const float th = 1.0f - 2.0f / (e + 1.0f); return 0.5f * x * (1.0f + th); }
__device__ __forceinline__ void lru_scan_naive(Frame& F) {
    if (F.bx >= 192 || F.wave != 0) return;
    const int gid = F.bx * 64 + F.lane, b = gid / LRU_W, ch = gid % LRU_W, blk = ch / LRU_BW, dch = ch % LRU_BW;
    const bf16* G = wsA(F, A_LG); const bf16* UC = wsA(F, A_LUC); bf16* Y = wsA(F, A_LY);
    const float* wr = inF(F, I_LRU_WR) + (size_t)blk * LRU_BW * LRU_BW + dch; const float* wi = inF(F, I_LRU_WI) + (size_t)blk * LRU_BW * LRU_BW + dch;
    const float br = inF(F, I_LRU_BR)[ch], bi = inF(F, I_LRU_BI)[ch], lam = inF(F, I_LRU_LAM)[ch];
    const float sp = (lam > 0.f ? 0.f : -lam) + log1pf(expf(-fabsf(lam)));
    const float cneg = -8.0f * sp; float hst = 0.f;
    for (int t = 0; t < SEQ; ++t) {
        const size_t row = (size_t)b * SEQ + t; const bf16* up = UC + row * LRU_W + blk * LRU_BW; float ar = br, ai = bi;
#pragma unroll 16
        for (int c = 0; c < LRU_BW; ++c) { const float uu = bf2f(up[c]); ar += uu * wr[(size_t)c * LRU_BW]; ai += uu * wi[(size_t)c * LRU_BW]; }
        const float r = 1.0f / (1.0f + expf(-ar)), ig = 1.0f / (1.0f + expf(-ai));
        const float la = cneg * r, a = expf(la), bb = sqrtf(-expm1f(2.0f * la)) * (ig * bf2f(UC[row * LRU_W + ch]));
        hst = a * hst + bb;
        Y[row * LRU_W + ch] = (bf16)f2bf(hst * gelu_tanh(bf2f(G[row * LRU_W + ch])));
    }
}
__device__ __forceinline__ void swa_naive(Frame& F) {
    const int gw = F.bx * NWAVES + F.wave, NGW = F.G * NWAVES, lane = F.lane;
    const bf16* Q = wsA(F, A_SQ); const bf16* K = wsA(F, A_SK); const bf16* V = wsA(F, A_SV); bf16* O = wsA(F, A_SO); const float* sinks = inF(F, I_SWA_SINK);
    LAS float* pl = (LAS float*)F.lds + F.wave * 128;
    for (int it = gw; it < M * SWA_HQ; it += NGW) {
        const int row = it >> 4, qh = it & 15, kvh = qh >> 2, t = row & (SEQ - 1);
        const v4u* qp = (const v4u*)(Q + (size_t)row * 1024 + qh * 64); v4u qv[8];
#pragma unroll
        for (int i = 0; i < 8; ++i) qv[i] = qp[i];
        float sc[2];
#pragma unroll
        for (int kk = 0; kk < 2; ++kk) {
            const int dj = 127 - lane - 64 * kk;
            float s = -INFINITY;
            if (t - dj >= 0) { const v4u* kp = (const v4u*)(K + (size_t)(row - dj) * 256 + kvh * 64); s = 0.f;
#pragma unroll
                for (int i = 0; i < 8; ++i) { const v4u a = qv[i], bb = kp[i];
                    s += bflo(a.x) * bflo(bb.x) + bfhi(a.x) * bfhi(bb.x) + bflo(a.y) * bflo(bb.y) + bfhi(a.y) * bfhi(bb.y) + bflo(a.z) * bflo(bb.z) + bfhi(a.z) * bfhi(bb.z) + bflo(a.w) * bflo(bb.w) + bfhi(a.w) * bfhi(bb.w); } }
            sc[kk] = s;
        }
        const float sk = sinks[qh];
        const float mx = fmaxf(wave_max(fmaxf(sc[0], sc[1])), sk);
        const float p0 = expf(sc[0] - mx), p1 = expf(sc[1] - mx);
        const float den = wave_sum(p0 + p1) + expf(sk - mx), inv = 1.0f / den;
        pl[127 - lane] = p0 * inv; pl[63 - lane] = p1 * inv;
        LDS_WAIT(); asm volatile("" ::: "memory");
        float o = 0.f; const int nk = t < 127 ? t + 1 : 128;
#pragma unroll 8
        for (int dj = 0; dj < nk; ++dj) o += pl[dj] * bf2f(V[(size_t)(row - dj) * 256 + kvh * 64 + lane]);
        O[(size_t)row * 1024 + qh * 64 + lane] = (bf16)f2bf(o);
        LDS_WAIT(); asm volatile("" ::: "memory");
    }
}
typedef short bf16x8v __attribute__((ext_vector_type(8)));
typedef float f32x4v __attribute__((ext_vector_type(4)));
__device__ __forceinline__ float sigmoid_f(float x) { return 1.0f / (1.0f + __expf(-x)); }
__device__ __forceinline__ void lru_fused(Frame& F) {
    const int w = F.bx; if (w >= 256) return;
    const int b = w >> 5, blk = (w >> 2) & 7, cg = w & 3, tid = F.tid, lane = F.lane, wv = F.wave, fr = lane & 15, fq = lane >> 4;
    LAS unsigned short* U = (LAS unsigned short*)F.lds;
    LAS float* SA = (LAS float*)(F.lds + 51200);
    LAS float* SB = SA + 128 * 48;
    LAS float* GA = SB + 128 * 48;
    LAS float* GB = GA + 8 * 48;
    LAS float* HC = GB + 8 * 48;
    const int chb = blk * LRU_BW, c0 = cg * 48;
    const bf16* UR = wsA(F, A_LU); const bf16* G = wsA(F, A_LG); bf16* Y = wsA(F, A_LY);
    const float* cw = inF(F, I_LRU_CW); const float* cb = inF(F, I_LRU_CB);
    LAS unsigned short* Wt = (LAS unsigned short*)(F.lds + 106496);
    {
        const float* wr = inF(F, I_LRU_WR) + (size_t)blk * LRU_BW * LRU_BW; const float* wi = inF(F, I_LRU_WI) + (size_t)blk * LRU_BW * LRU_BW;
        for (int id = tid; id < 96 * 192; id += 512) { const int k = id / 96, n = id % 96; const float v = (n < 48 ? wr : wi)[(size_t)k * LRU_BW + c0 + (n % 48)]; Wt[n * 200 + k] = (unsigned short)f2bf(v); }
    }
    float br[3], bi[3], cn[3];
#pragma unroll
    for (int j = 0; j < 3; ++j) { const int gch = chb + c0 + 16 * j + fr; br[j] = inF(F, I_LRU_BR)[gch]; bi[j] = inF(F, I_LRU_BI)[gch]; const float lam = inF(F, I_LRU_LAM)[gch];
        cn[j] = -8.0f * ((lam > 0.f ? 0.f : -lam) + log1pf(expf(-fabsf(lam)))); }
    const int sch = tid % 48, sg = tid / 48;
    if (tid < 96) HC[tid] = 0.f;
    __syncthreads();
    for (int seg = 0; seg < SEQ / 128; ++seg) {
        const size_t row0 = (size_t)b * SEQ + (size_t)seg * 128;
#pragma unroll 2
        for (int i = 0; i < 6; ++i) {
            const int id = tid + 512 * i, token = id / 24, c8 = (id % 24) * 8, t = seg * 128 + token; float a[8];
            { const f32x4v b0 = *(const f32x4v*)(cb + chb + c8), b1 = *(const f32x4v*)(cb + chb + c8 + 4); a[0] = b0[0]; a[1] = b0[1]; a[2] = b0[2]; a[3] = b0[3]; a[4] = b1[0]; a[5] = b1[1]; a[6] = b1[2]; a[7] = b1[3]; }
#pragma unroll
            for (int wq = 0; wq < 4; ++wq) { if (t - 3 + wq >= 0) { const v4u u = *(const v4u*)(UR + (row0 + token - 3 + wq) * LRU_W + chb + c8);
                const f32x4v k0 = *(const f32x4v*)(cw + wq * LRU_W + chb + c8), k1 = *(const f32x4v*)(cw + wq * LRU_W + chb + c8 + 4);
                a[0] += k0[0] * bflo(u.x); a[1] += k0[1] * bfhi(u.x); a[2] += k0[2] * bflo(u.y); a[3] += k0[3] * bfhi(u.y); a[4] += k1[0] * bflo(u.z); a[5] += k1[1] * bfhi(u.z); a[6] += k1[2] * bflo(u.w); a[7] += k1[3] * bfhi(u.w); } }
            v4u o; o.x = pk2(a[0], a[1]); o.y = pk2(a[2], a[3]); o.z = pk2(a[4], a[5]); o.w = pk2(a[6], a[7]);
            *(LAS v4u*)(U + token * 200 + c8) = o;
        }
        __syncthreads();
        f32x4v acc[6];
#pragma unroll
        for (int nt = 0; nt < 6; ++nt) acc[nt] = (f32x4v){0.f, 0.f, 0.f, 0.f};
#pragma unroll
        for (int ks = 0; ks < 6; ++ks) { const bf16x8v A = *(const LAS bf16x8v*)(U + (16 * wv + fr) * 200 + 32 * ks + 8 * fq);
#pragma unroll
            for (int nt = 0; nt < 6; ++nt) { const bf16x8v Bv = *(const LAS bf16x8v*)(Wt + (16 * nt + fr) * 200 + 32 * ks + 8 * fq); acc[nt] = __builtin_amdgcn_mfma_f32_16x16x32_bf16(A, Bv, acc[nt], 0, 0, 0); } }
#pragma unroll
        for (int j = 0; j < 3; ++j)
#pragma unroll
            for (int e = 0; e < 4; ++e) { const int token = 16 * wv + 4 * fq + e;
                const float r = sigmoid_f(acc[j][e] + br[j]), ig = sigmoid_f(acc[3 + j][e] + bi[j]), la = cn[j] * r, a = __expf(la);
                const float uval = bf2f(U[token * 200 + c0 + 16 * j + fr]);
                SA[token * 48 + 16 * j + fr] = a; SB[token * 48 + 16 * j + fr] = sqrtf(-expm1f(2.0f * la)) * (ig * uval); }
        __syncthreads();
        if (tid < 384) { float A = 1.f, B = 0.f;
#pragma unroll
            for (int i = 0; i < 16; ++i) { const int tk = 16 * sg + i; const float a = SA[tk * 48 + sch], bb = SB[tk * 48 + sch]; B = a * B + bb; A *= a; }
            GA[sg * 48 + sch] = A; GB[sg * 48 + sch] = B; }
        __syncthreads();
        if (tid < 384) { float h = HC[(seg & 1) * 48 + sch];
            for (int g = 0; g < sg; ++g) h = GA[g * 48 + sch] * h + GB[g * 48 + sch];
            const size_t gofs = (row0 + 16 * sg) * LRU_W + chb + c0 + sch;
#pragma unroll
            for (int i = 0; i < 16; ++i) { const int tk = 16 * sg + i; h = SA[tk * 48 + sch] * h + SB[tk * 48 + sch];
                Y[gofs + (size_t)i * LRU_W] = (bf16)f2bf(h * gelu_tanh(bf2f(G[gofs + (size_t)i * LRU_W]))); }
            if (sg == 7) HC[((seg + 1) & 1) * 48 + sch] = h; }
        __syncthreads();
    }
}
typedef short v4s16 __attribute__((ext_vector_type(4)));
typedef unsigned u32x2v __attribute__((ext_vector_type(2)));
__device__ __forceinline__ v4s16 ds_tr16(const LAS unsigned short* p) { return __builtin_amdgcn_ds_read_tr16_b64_v4i16((LAS v4s16*)p); }
__device__ __forceinline__ bf16x8v frag_tr(const LAS unsigned short* X, int P, int k0, int c0, int lane) {
    const int g = lane >> 4, i = lane & 15, q = i >> 2, p = i & 3;
    const LAS unsigned short* a0 = X + (k0 + 8 * g + q) * P + c0 + 4 * p;
    const v4s16 lo = ds_tr16(a0), hi = ds_tr16(a0 + 4 * P);
    return (bf16x8v){lo[0], lo[1], lo[2], lo[3], hi[0], hi[1], hi[2], hi[3]};
}
constexpr size_t A_RS = 128 * MiB;
__device__ __forceinline__ void ret_state(Frame& F) {
    const int w = F.bx; if (w >= 256) return;
    const int b = w >> 5, h = (w >> 3) & 3, vs = w & 7, tid = F.tid, lane = F.lane, wv = F.wave, fr = lane & 15, fq = lane >> 4;
    LAS unsigned short* Kt = (LAS unsigned short*)F.lds;
    LAS unsigned short* Vt = (LAS unsigned short*)(F.lds + 67584);
    const bf16* K = wsA(F, A_RK); const bf16* V = wsA(F, A_RV); bf16* ST = wsA(F, A_RS);
    const float cdec = exp2f(256.0f * log2f(1.0f - exp2f(-5.0f - (float)h)));
    f32x4v acc[2][4];
#pragma unroll
    for (int m = 0; m < 2; ++m)
#pragma unroll
        for (int n = 0; n < 4; ++n) acc[m][n] = (f32x4v){0.f, 0.f, 0.f, 0.f};
    for (int blk = 0; blk < 8; ++blk) {
        if (blk > 0) {
            bf16* st = ST + ((size_t)((b * 4 + h) * 7 + (blk - 1)) * 512 + vs * 64) * 256;
#pragma unroll
            for (int m = 0; m < 2; ++m)
#pragma unroll
                for (int n = 0; n < 4; ++n) { u32x2v o; o.x = pk2(acc[m][n][0], acc[m][n][1]); o.y = pk2(acc[m][n][2], acc[m][n][3]);
                    *(u32x2v*)(st + (size_t)(16 * n + fr) * 256 + 32 * wv + 16 * m + 4 * fq) = o; }
        }
        if (blk == 7) break;
        for (int half = 0; half < 2; ++half) {
            const size_t r0 = (size_t)b * SEQ + (size_t)blk * 256 + (size_t)half * 128;
#pragma unroll
            for (int i = 0; i < 8; ++i) { const int id = tid + 512 * i, row = id >> 5, c16 = id & 31;
                *(LAS v4u*)(Kt + row * 264 + c16 * 8) = *(const v4u*)(K + (r0 + row) * 1024 + h * 256 + c16 * 8); }
#pragma unroll
            for (int i = 0; i < 2; ++i) { const int id = tid + 512 * i, row = id >> 3, c16 = id & 7;
                *(LAS v4u*)(Vt + row * 72 + c16 * 8) = *(const v4u*)(V + (r0 + row) * 2048 + h * 512 + vs * 64 + c16 * 8); }
            __syncthreads();
#pragma unroll
            for (int ks = 0; ks < 4; ++ks) {
                bf16x8v X[2], Y[4];
#pragma unroll
                for (int m = 0; m < 2; ++m) X[m] = frag_tr(Kt, 264, 32 * ks, 32 * wv + 16 * m, lane);
#pragma unroll
                for (int n = 0; n < 4; ++n) Y[n] = frag_tr(Vt, 72, 32 * ks, 16 * n, lane);
#pragma unroll
                for (int m = 0; m < 2; ++m)
#pragma unroll
                    for (int n = 0; n < 4; ++n) acc[m][n] = __builtin_amdgcn_mfma_f32_16x16x32_bf16(X[m], Y[n], acc[m][n], 0, 0, 0);
            }
            __syncthreads();
        }
#pragma unroll
        for (int m = 0; m < 2; ++m)
#pragma unroll
            for (int n = 0; n < 4; ++n) acc[m][n] = acc[m][n] * cdec;
    }
}
__device__ __forceinline__ void ret_out(Frame& F) {
    const int w = F.bx; if (w >= 256) return;
    const int b = w >> 5, h = (w >> 3) & 3, blk = w & 7, tid = F.tid, lane = F.lane, wv = F.wave, fr = lane & 15, fq = lane >> 4;
    LAS unsigned short* Qt = (LAS unsigned short*)F.lds;
    LAS unsigned short* Kt = (LAS unsigned short*)(F.lds + 67584);
    LAS unsigned short* Vt = (LAS unsigned short*)(F.lds + 84480);
    LAS unsigned short* Pt = (LAS unsigned short*)(F.lds + 117760);
    LAS float* red = (LAS float*)(F.lds + 67584);
    const bf16* Q = wsA(F, A_RQ); const bf16* K = wsA(F, A_RK); bf16* V = wsA(F, A_RV);
    const bf16* ST = wsA(F, A_RS) + ((size_t)((b * 4 + h) * 7 + (blk - 1)) * 512) * 256;
    const size_t R0 = (size_t)b * SEQ + (size_t)blk * 256;
    for (int sub = 1; sub >= 0; --sub) {
#pragma unroll
        for (int i = 0; i < 8; ++i) { const int id = tid + 512 * i, row = id >> 5, c16 = id & 31;
            *(LAS v4u*)(Qt + row * 264 + c16 * 8) = *(const v4u*)(Q + (R0 + 128 * sub + row) * 1024 + h * 256 + c16 * 8); }
        f32x4v acc[8][4];
#pragma unroll
        for (int m = 0; m < 8; ++m)
#pragma unroll
            for (int n = 0; n < 4; ++n) acc[m][n] = (f32x4v){0.f, 0.f, 0.f, 0.f};
        const int nkb = 4 * (sub + 1);
        for (int kb = 0; kb < nkb; ++kb) {
#pragma unroll
            for (int i = 0; i < 2; ++i) { const int id = tid + 512 * i, row = id >> 5, c16 = id & 31;
                *(LAS v4u*)(Kt + row * 264 + c16 * 8) = *(const v4u*)(K + (R0 + 32 * kb + row) * 1024 + h * 256 + c16 * 8); }
#pragma unroll
            for (int i = 0; i < 4; ++i) { const int id = tid + 512 * i, row = id >> 6, c16 = id & 63;
                *(LAS v4u*)(Vt + row * 520 + c16 * 8) = *(const v4u*)(V + (R0 + 32 * kb + row) * 2048 + h * 512 + c16 * 8); }
            __syncthreads();
            f32x4v sc[2] = {(f32x4v){0.f, 0.f, 0.f, 0.f}, (f32x4v){0.f, 0.f, 0.f, 0.f}};
#pragma unroll
            for (int ks = 0; ks < 8; ++ks) { const bf16x8v Yq = *(const LAS bf16x8v*)(Qt + (16 * wv + fr) * 264 + 32 * ks + 8 * fq);
#pragma unroll
                for (int nt = 0; nt < 2; ++nt) { const bf16x8v Xk = *(const LAS bf16x8v*)(Kt + (16 * nt + fr) * 264 + 32 * ks + 8 * fq); sc[nt] = __builtin_amdgcn_mfma_f32_16x16x32_bf16(Xk, Yq, sc[nt], 0, 0, 0); } }
            const int iloc = 128 * sub + 16 * wv + fr;
#pragma unroll
            for (int nt = 0; nt < 2; ++nt) { const int j0 = 32 * kb + 16 * nt + 4 * fq; float p[4];
#pragma unroll
                for (int e = 0; e < 4; ++e) p[e] = (j0 + e <= iloc) ? sc[nt][e] : 0.f;
                u32x2v o; o.x = pk2(p[0], p[1]); o.y = pk2(p[2], p[3]); *(LAS u32x2v*)(Pt + (16 * wv + fr) * 40 + 16 * nt + 4 * fq) = o; }
            __syncthreads();
            bf16x8v Xv[4];
#pragma unroll
            for (int n = 0; n < 4; ++n) Xv[n] = frag_tr(Vt, 520, 0, 64 * wv + 16 * n, lane);
#pragma unroll
            for (int m = 0; m < 8; ++m) { const bf16x8v Yp = *(const LAS bf16x8v*)(Pt + (16 * m + fr) * 40 + 8 * fq);
#pragma unroll
                for (int n = 0; n < 4; ++n) acc[m][n] = __builtin_amdgcn_mfma_f32_16x16x32_bf16(Xv[n], Yp, acc[m][n], 0, 0, 0); }
            __syncthreads();
        }
        if (blk > 0) {
#pragma unroll 2
            for (int ks = 0; ks < 8; ++ks) { bf16x8v Xs[4];
#pragma unroll
                for (int n = 0; n < 4; ++n) Xs[n] = __builtin_bit_cast(bf16x8v, *(const v4u*)(ST + (size_t)(64 * wv + 16 * n + fr) * 256 + 32 * ks + 8 * fq));
#pragma unroll
                for (int m = 0; m < 8; ++m) { const bf16x8v Yq = *(const LAS bf16x8v*)(Qt + (16 * m + fr) * 264 + 32 * ks + 8 * fq);
#pragma unroll
                    for (int n = 0; n < 4; ++n) acc[m][n] = __builtin_amdgcn_mfma_f32_16x16x32_bf16(Xs[n], Yq, acc[m][n], 0, 0, 0); } }
        }
        float ss[8];
#pragma unroll
        for (int m = 0; m < 8; ++m) { float s = 0.f;
#pragma unroll
            for (int n = 0; n < 4; ++n) s += (acc[m][n][0] * acc[m][n][0] + acc[m][n][1] * acc[m][n][1]) + (acc[m][n][2] * acc[m][n][2] + acc[m][n][3] * acc[m][n][3]);
            s += __shfl_xor(s, 16); s += __shfl_xor(s, 32); ss[m] = s; }
        if (fq == 0) {
#pragma unroll
            for (int m = 0; m < 8; ++m) red[wv * 128 + 16 * m + fr] = ss[m]; }
        __syncthreads();
#pragma unroll
        for (int m = 0; m < 8; ++m) { float s = 0.f;
#pragma unroll
            for (int ww = 0; ww < 8; ++ww) s += red[ww * 128 + 16 * m + fr];
            const float rs = 1.0f / sqrtf(s * (1.0f / 512.0f) + 1e-6f);
            bf16* op = V + (R0 + 128 * sub + 16 * m + fr) * 2048 + h * 512 + 64 * wv + 4 * fq;
#pragma unroll
            for (int n = 0; n < 4; ++n) { u32x2v o; o.x = pk2(acc[m][n][0] * rs, acc[m][n][1] * rs); o.y = pk2(acc[m][n][2] * rs, acc[m][n][3] * rs); *(u32x2v*)(op + 16 * n) = o; } }
        __syncthreads();
    }
}
__device__ __forceinline__ bf16x8v frag_tr_perm(const LAS unsigned short* X, int P, int k0, int c0, int lane) {
    const int g = lane >> 4, i = lane & 15, q = i >> 2, p = i & 3;
    const LAS unsigned short* a0 = X + (k0 + 4 * g + q) * P + c0 + 4 * p;
    const v4s16 lo = ds_tr16(a0), hi = ds_tr16(a0 + 16 * P);
    return (bf16x8v){lo[0], lo[1], lo[2], lo[3], hi[0], hi[1], hi[2], hi[3]};
}
__device__ __forceinline__ void swa_mfma(Frame& F) {
    const int tid = F.tid, lane = F.lane, wv = F.wave, fr = lane & 15, fq = lane >> 4;
    LAS unsigned short* Kt = (LAS unsigned short*)F.lds;
    LAS unsigned short* Vt = (LAS unsigned short*)(F.lds + 36864);
    const bf16* Q = wsA(F, A_SQ); const bf16* K = wsA(F, A_SK); const bf16* V = wsA(F, A_SV); bf16* O = wsA(F, A_SO); const float* sinks = inF(F, I_SWA_SINK);
    for (int i = tid; i < 16 * 72 / 2; i += 512) ((LAS unsigned*)(Vt + 256 * 72))[i] = 0u;
    for (int it = F.bx; it < BATCH * SWA_HKV * (SEQ / 128); it += F.G) {
        const int nb = it & 15, kvh = (it >> 4) & 3, b = it >> 6;
        const long R0 = (long)b * SEQ + nb * 128;
#pragma unroll
        for (int i = 0; i < 4; ++i) { const int id = tid + 512 * i, p = id >> 3, c16 = id & 7; v4u kv = (v4u){0u, 0u, 0u, 0u}, vv = kv;
            if (nb > 0 || p >= 128) { kv = *(const v4u*)(K + (R0 - 128 + p) * 256 + kvh * 64 + c16 * 8); vv = *(const v4u*)(V + (R0 - 128 + p) * 256 + kvh * 64 + c16 * 8); }
            *(LAS v4u*)(Kt + p * 72 + c16 * 8) = kv; *(LAS v4u*)(Vt + p * 72 + c16 * 8) = vv; }
        __syncthreads();
        const int qh = kvh * 4 + (wv >> 1); const float sk = sinks[qh] * 1.4426950408889634f;
        for (int mt = 0; mt < 4; ++mt) {
            const int r = 64 * (wv & 1) + 16 * mt, iloc = r + fr;
            bf16x8v Yq[2];
#pragma unroll
            for (int ks = 0; ks < 2; ++ks) Yq[ks] = __builtin_bit_cast(bf16x8v, *(const v4u*)(Q + (R0 + r + fr) * 1024 + qh * 64 + 32 * ks + 8 * fq));
            f32x4v sc[9];
#pragma unroll
            for (int t = 0; t < 9; ++t) { sc[t] = (f32x4v){0.f, 0.f, 0.f, 0.f};
#pragma unroll
                for (int ks = 0; ks < 2; ++ks) { const bf16x8v Xk = *(const LAS bf16x8v*)(Kt + (r + 16 * t + fr) * 72 + 32 * ks + 8 * fq); sc[t] = __builtin_amdgcn_mfma_f32_16x16x32_bf16(Xk, Yq[ks], sc[t], 0, 0, 0); } }
            float mx = -INFINITY;
#pragma unroll
            for (int t = 0; t < 9; ++t)
#pragma unroll
                for (int e = 0; e < 4; ++e) { const int p = r + 16 * t + 4 * fq + e; const bool ok = (p >= iloc + 1) && (p <= iloc + 128) && (nb > 0 || p >= 128);
                    const float s = ok ? sc[t][e] * 1.4426950408889634f : -INFINITY; sc[t][e] = s; mx = fmaxf(mx, s); }
            mx = fmaxf(mx, __shfl_xor(mx, 16)); mx = fmaxf(mx, __shfl_xor(mx, 32)); mx = fmaxf(mx, sk);
            float den = 0.f;
#pragma unroll
            for (int t = 0; t < 9; ++t)
#pragma unroll
                for (int e = 0; e < 4; ++e) { const float pe = __builtin_amdgcn_exp2f(sc[t][e] - mx); sc[t][e] = pe; den += pe; }
            den += __shfl_xor(den, 16); den += __shfl_xor(den, 32); den += __builtin_amdgcn_exp2f(sk - mx);
            f32x4v o[4];
#pragma unroll
            for (int n = 0; n < 4; ++n) o[n] = (f32x4v){0.f, 0.f, 0.f, 0.f};
#pragma unroll
            for (int s5 = 0; s5 < 5; ++s5) {
                v4u pw; pw.x = pk2(sc[2 * s5][0], sc[2 * s5][1]); pw.y = pk2(sc[2 * s5][2], sc[2 * s5][3]);
                if (s5 < 4) { pw.z = pk2(sc[2 * s5 + 1][0], sc[2 * s5 + 1][1]); pw.w = pk2(sc[2 * s5 + 1][2], sc[2 * s5 + 1][3]); } else { pw.z = 0u; pw.w = 0u; }
                const bf16x8v Yp = __builtin_bit_cast(bf16x8v, pw);
#pragma unroll
                for (int n = 0; n < 4; ++n) { const bf16x8v Xv = frag_tr_perm(Vt, 72, r + 32 * s5, 16 * n, lane); o[n] = __builtin_amdgcn_mfma_f32_16x16x32_bf16(Xv, Yp, o[n], 0, 0, 0); }
            }
            const float inv = 1.0f / den;
            bf16* op = O + (R0 + r + fr) * 1024 + qh * 64 + 4 * fq;
#pragma unroll
            for (int n = 0; n < 4; ++n) { u32x2v ov; ov.x = pk2(o[n][0] * inv, o[n][1] * inv); ov.y = pk2(o[n][2] * inv, o[n][3] * inv); *(u32x2v*)(op + 16 * n) = ov; }
        }
        __syncthreads();
    }
}
enum Kind { K_PROLOGUE = 0, K_G_RETQKV, K_RET_CORE, K_RET_NORM, K_G_GATE, K_G_RES, K_G_FFNUP, K_G_LRUIN, K_LRU_CONV, K_LRU_SCAN, K_G_SWAQKV, K_SWA_ATT, K_FINAL };
struct PD { int kind, layer, sub; };
constexpr int N_PHASES = 1 + 7 + 6 + 5 + 7 + 1;
__host__ __device__ __forceinline__ int ret_kind(int p) { return p == 0 ? K_G_RETQKV : p == 1 ? K_RET_CORE : p == 2 ? K_RET_NORM : p == 3 ? K_G_GATE : p == 4 ? K_G_RES : p == 5 ? K_G_FFNUP : K_G_RES; }
__host__ __device__ __forceinline__ int lru_kind(int p) { return p == 0 ? K_G_LRUIN : p == 1 ? K_LRU_CONV : p == 2 ? K_LRU_SCAN : p == 3 ? K_G_RES : p == 4 ? K_G_FFNUP : K_G_RES; }
__host__ __device__ __forceinline__ int swa_kind(int p) { return p == 0 ? K_G_SWAQKV : p == 1 ? K_SWA_ATT : p == 2 ? K_G_RES : p == 3 ? K_G_FFNUP : K_G_RES; }
__host__ __device__ __forceinline__ PD phase_desc(int ph) {
    PD d{K_FINAL, 0, 0};
    if (ph == 0) { d.kind = K_PROLOGUE; return d; }
    int p = ph - 1;
    if (p < 7) { d.layer = 0; d.kind = ret_kind(p); d.sub = (p == 6); return d; } p -= 7;
    if (p < 6) { d.layer = 1; d.kind = lru_kind(p); d.sub = (p == 5); return d; } p -= 6;
    if (p < 5) { d.layer = 2; d.kind = swa_kind(p); d.sub = (p == 4); return d; } p -= 5;
    if (p < 7) { d.layer = 3; d.kind = ret_kind(p); d.sub = (p == 6); return d; }
    return d;
}

__global__ void __launch_bounds__(NWAVES * 64, 2) mk_fwd(Args args_unused) {
    extern __shared__ __attribute__((aligned(16))) unsigned char lds[];
    Frame F;
    F.lds = (LAS unsigned char*)lds; F.MISC = (volatile LAS unsigned*)(F.lds + MISC_OFF);
    F.tid = threadIdx.x; F.lane = F.tid & 63; F.wave = __builtin_amdgcn_readfirstlane(F.tid >> 6); F.G = gridDim.x;
    F.ap = (CArgs)__builtin_amdgcn_kernarg_segment_ptr(); F.ws = F.ap->ws; F.ctl = (gu32*)(F.ws + WS_CTL);
    for (int u = F.tid; u < (LDS_BYTES - LDSCTL_OFF) / 4; u += NWAVES * 64) ((LAS unsigned*)(F.lds + LDSCTL_OFF))[u] = 0u;
    __syncthreads();
    XcdBarrier bar = xcd_barrier_post((unsigned*)(F.ctl + CW_BAR) + F.ap->li * XCD_BAR_WORDS, F.MISC + 8);
    const int ph_hi = F.ap->ph_hi;
    for (int ph = F.ap->ph_lo; ph < ph_hi; ++ph) {
        { int t_ = threadIdx.x; asm volatile("" : "+v"(t_)); F.tid = t_; F.lane = t_ & 63; F.wave = __builtin_amdgcn_readfirstlane(t_ >> 6); int bx_ = blockIdx.x; asm volatile("" : "+s"(bx_)); F.bx = bx_; }
        { CArgs ap_ = (CArgs)__builtin_amdgcn_kernarg_segment_ptr(); asm volatile("" : "+s"(ap_)); F.ap = ap_; unsigned char* ws_ = ap_->ws; asm volatile("" : "+s"(ws_)); F.ws = ws_; }
        bf16* XN = (bf16*)(F.ws + WS_XN); float* const outp = F.ap->out;
        const PD d = phase_desc(ph);
        const int L = d.layer, rj = (L == 3) ? 1 : 0;
        switch (d.kind) {
        case K_PROLOGUE: p0_prologue(F); break;
        case K_G_RETQKV: {
            pg8::Gemm g{XN, wsW(F, WO_RETIN + (size_t)rj * 6144 * 1024), M, 4096, 1024}; pg8::StaticOrder S; S.init(M, 4096, F.G, F.bx);
            pg8::EpiRetQKV E{wsA(F, A_RQ), wsA(F, A_RK), wsA(F, A_RV), wsSSQ(F, 2 * L), (const unsigned*)(F.ws + WS_ROPEA)};
            pg8::gemm_phase<pg8::EpiRetQKV, pg8::StaticOrder, true, true>(F.lds, g, S, E);
        } break;
        case K_RET_CORE: ret_state(F); break;
        case K_RET_NORM: ret_out(F); break;
        case K_G_GATE: {
            pg8::Gemm g{XN, wsW(F, WO_RETIN + (size_t)rj * 6144 * 1024 + (size_t)4096 * 1024), M, 2048, 1024}; pg8::StaticOrder S; S.init(M, 2048, F.G, F.bx);
            pg8::EpiGate E{wsA(F, A_RV), wsSSQ(F, 2 * L)};
            pg8::gemm_phase<pg8::EpiGate, pg8::StaticOrder, true, true>(F.lds, g, S, E);
        } break;
        case K_G_RES: {
            const bf16* A; const bf16* W; int K; const float* bias = nullptr; int si;
            if (d.sub == 1) { A = wsA(F, A_H); W = wsW(F, WO_FFNDN + (size_t)L * 1024 * 2816); K = 2816; si = 2 * L + 2; }
            else { si = 2 * L + 1;
                if (L == 1) { A = wsA(F, A_LY); W = wsW(F, WO_LRUOUT); K = 1536; }
                else if (L == 2) { A = wsA(F, A_SO); W = wsW(F, WO_SWAOUT); K = 1024; bias = inF(F, I_SWA_BOUT); }
                else { A = wsA(F, A_RV); W = wsW(F, WO_RETOUT + (size_t)rj * 1024 * 2048); K = 2048; } }
            const float* base = (L == 0 && d.sub == 0) ? inF(F, I_X) : (const float*)outp;
            pg8::Gemm g{A, W, M, 1024, K}; pg8::StaticOrder S; S.init(M, 1024, F.G, F.bx);
            pg8::EpiRes E{base, outp, XN, wsSSQ(F, si), bias};
            pg8::gemm_phase<pg8::EpiRes, pg8::StaticOrder, false, true>(F.lds, g, S, E);
        } break;
        case K_G_FFNUP: {
            pg8::Gemm g{XN, wsW(F, WO_FFNGU + (size_t)L * 5632 * 1024), M, 5632, 1024}; pg8::StaticOrder S; S.init(M, 5632, F.G, F.bx);
            pg8::EpiSwiGLU E{wsA(F, A_H), wsSSQ(F, 2 * L + 1)};
            pg8::gemm_phase<pg8::EpiSwiGLU, pg8::StaticOrder, true, true>(F.lds, g, S, E);
        } break;
        case K_G_LRUIN: {
            pg8::Gemm g{XN, wsW(F, WO_LRUIN), M, 3072, 1024}; pg8::StaticOrder S; S.init(M, 3072, F.G, F.bx);
            pg8::EpiLruIn E{wsA(F, A_LG), wsA(F, A_LU), wsSSQ(F, 2 * L)};
            pg8::gemm_phase<pg8::EpiLruIn, pg8::StaticOrder, true, true>(F.lds, g, S, E);
        } break;
        case K_LRU_CONV: break;
        case K_LRU_SCAN: lru_fused(F); break;
        case K_G_SWAQKV: {
            pg8::Gemm g{XN, wsW(F, WO_SWAQKV), M, 1536, 1024}; pg8::StaticOrder S; S.init(M, 1536, F.G, F.bx);
            pg8::EpiSwaQKV E{wsA(F, A_SQ), wsA(F, A_SK), wsA(F, A_SV), wsSSQ(F, 2 * L), (const unsigned*)(F.ws + WS_ROPEB), inF(F, I_SWA_BQKV)};
            pg8::gemm_phase<pg8::EpiSwaQKV, pg8::StaticOrder, true, true>(F.lds, g, S, E);
        } break;
        case K_SWA_ATT: swa_mfma(F); break;
        default: final_norm(F); break;
        }
        if (ph + 1 < ph_hi) xcd_barrier(bar);
    }
}

extern "C" void kernel_launch(void* const* d_in, const int* in_sizes, int n_in, void* d_out, int out_size, void* d_ws, size_t ws_size, hipStream_t stream) {
    static int grid = 0;
    if (grid == 0) {
        if (n_in != N_IN || in_sizes[0] != M * DM || out_size != M * DM || ws_size < WS_END) { fprintf(stderr, "kernel_launch: unexpected shapes: n_in %d in0 %d out %d ws %zu (need %zu); nothing launched\n", n_in, n_in > 0 ? in_sizes[0] : -1, out_size, ws_size, (size_t)WS_END); grid = -1; return; }
        int dev = 0, cus = 0;
        if (hipGetDevice(&dev) != hipSuccess || hipDeviceGetAttribute(&cus, hipDeviceAttributeMultiprocessorCount, dev) != hipSuccess) { fprintf(stderr, "kernel_launch: device query failed\n"); grid = -1; return; }
        if (hipFuncSetAttribute((const void*)mk_fwd, hipFuncAttributeMaxDynamicSharedMemorySize, LDS_BYTES) != hipSuccess) { fprintf(stderr, "kernel_launch: hipFuncSetAttribute failed\n"); grid = -1; return; }
        int per_cu = 0;
        if (hipOccupancyMaxActiveBlocksPerMultiprocessor(&per_cu, (const void*)mk_fwd, NWAVES * 64, LDS_BYTES) != hipSuccess || per_cu < 1) fprintf(stderr, "kernel_launch: note: occupancy query reports %d workgroups per CU\n", per_cu);
        (void)hipGetLastError();
        grid = cus;
        if (grid != 256) fprintf(stderr, "kernel_launch: note: %d CUs (built for 256)\n", grid);
    }
    if (grid < 0) return;
    if (hipMemsetAsync((char*)d_ws + WS_CTL, 0, CTL_ZERO_BYTES, stream) != hipSuccess) { fprintf(stderr, "kernel_launch: hipMemsetAsync failed\n"); return; }
    Args a{};
    for (int i = 0; i < N_IN; ++i) a.in[i] = d_in[i];
    a.out = (float*)d_out; a.ws = (unsigned char*)d_ws;
#ifndef MK_CUTS
    a.ph_lo = 0; a.ph_hi = N_PHASES; a.li = 0;
    hipLaunchKernelGGL(mk_fwd, dim3(grid), dim3(NWAVES * 64), LDS_BYTES, stream, a);
#else
    for (int ph = 0; ph < N_PHASES; ++ph) { a.ph_lo = ph; a.ph_hi = ph + 1; a.li = 0; hipLaunchKernelGGL(mk_fwd, dim3(grid), dim3(NWAVES * 64), LDS_BYTES, stream, a); }
#endif
    const hipError_t le = hipPeekAtLastError();
    if (le != hipSuccess) fprintf(stderr, "kernel_launch: launch failed: %s\n", hipGetErrorName(le));
}
```

```cpp
#include <hip/hip_runtime.h>
#include <cstdio>
#include <cstdint>
#include <cmath>
namespace pg8 {
#define PG8_LAS __attribute__((address_space(3)))
typedef unsigned short bf16_t;
typedef short bf16x8 __attribute__((ext_vector_type(8)));
typedef float f32x4 __attribute__((ext_vector_type(4)));
typedef unsigned u32x4 __attribute__((ext_vector_type(4)));
constexpr int BM = 256, BK = 64, HALF = 128, HTB = HALF * BK * 2  , STAGE_BYTES = 8 * HTB, NXCD = 8, WGM = 8;

__host__ __device__ __forceinline__ int lds_byte(int r, int c) { const int st = (r >> 4) * 2 + (c >> 5), rr = r & 15, cc = c & 31, ob = rr * 64 + cc * 2; return st * 1024 + (ob ^ (((ob >> 9) & 1) << 5)); }
__host__ __device__ __forceinline__ void stage_rc(int b, int& R, int& C) { const int st = b / 1024, sb = b % 1024, swz = sb ^ (((sb >> 9) & 1) << 5); R = (st >> 1) * 16 + swz / 64; C = (st & 1) * 32 + (swz % 64) / 2; }
__host__ __device__ __forceinline__ int perm32(int rho) { const int n = rho >> 4, i = rho & 15; return 8 * (i >> 2) + 4 * n + (i & 3); }

struct Unit { int pm, pn; };
struct Gemm { const bf16_t* A; const bf16_t* Bt; int M, N, K; };

struct StaticOrder {
    int nM, nN, nwg, G, c;
    __host__ __device__ void init(int M, int N, int G_, int c_) { nM = M / BM; nN = N / BM; nwg = nM * nN; G = G_; c = c_; }
    __host__ __device__ bool next(int i, Unit& u) const {
        const long L = (long)i * G + c; if (L >= nwg) return false;
        int wgid = (int)L; { const int q = nwg / NXCD, r = nwg % NXCD, xcd = wgid % NXCD, off = wgid / NXCD; wgid = (xcd < r ? xcd * (q + 1) : r * (q + 1) + (xcd - r) * q) + off; }
        const int nig = WGM * nN, gid = wgid / nig, fm = gid * WGM, gsz = (nM - fm) < WGM ? (nM - fm) : WGM;
        u.pm = fm + ((wgid % nig) % gsz); u.pn = (wgid % nig) / gsz; return true;
    }
    __device__ __forceinline__ void a_ready(const Unit&) const {}
    __device__ __forceinline__ void done(const Unit&) const {}
};

__device__ __forceinline__ unsigned cvt_pk_bf16(float lo, float hi) { unsigned r; asm volatile("v_cvt_pk_bf16_f32 %0, %1, %2" : "=v"(r) : "v"(lo), "v"(hi)); return r; }
typedef float f32x2 __attribute__((ext_vector_type(2)));
template <class Epi, class Sched, bool ALIGN_EPI = false, bool SP2 = false>
__device__ __forceinline__ void gemm_phase(PG8_LAS unsigned char* lds, const Gemm g, const Sched& S, const Epi& E) {
    int tid_l = threadIdx.x; asm volatile("" : "+v"(tid_l));
    const int tid = tid_l, wid = __builtin_amdgcn_readfirstlane(tid >> 6), lane = tid & 63, wr = wid >> 2, wc = wid & 3, fr = lane & 15, fq = lane >> 4;
    const int K = g.K, nt = K / BK;
    unsigned voffA[2], voffB[2];
#pragma unroll
    for (int i = 0; i < 2; ++i) { int R, C; stage_rc(tid * 16 + i * 8192, R, C); const int Rb = Epi::PERM ? ((R & ~31) + perm32(R & 31)) : R;
        voffA[i] = (unsigned)(R * K + C) * 2u; voffB[i] = (unsigned)(Rb * K + C) * 2u; }
    const size_t kstep = (size_t)(BK * 2);
    const size_t hstep = (size_t)HALF * K * 2;
    const size_t tstep = 2 * hstep;
    const unsigned ldsw = (unsigned)wid * 1024u;
    const int aoff = lds_byte(wr * 64 + fr, fq * 8), boff = lds_byte(wc * 32 + fr, fq * 8);
#define PG8_SA(b, h) (((b) * 2 + (h)) * HTB)
#define PG8_SB(b, h) ((4 + (b) * 2 + (h)) * HTB)
#define PG8_STAGE(bufoff, gbase, voff) do { _Pragma("unroll") for (int _i = 0; _i < 2; ++_i) \
        __builtin_amdgcn_global_load_lds((const unsigned*)((const char*)(gbase) + (voff)[_i]), (PG8_LAS unsigned*)(lds + (bufoff) + ldsw + _i * 8192), 16, 0, 0); } while (0)
#define PG8_LDA(dst, b, h) do { _Pragma("unroll") for (int m = 0; m < 4; ++m) _Pragma("unroll") for (int k = 0; k < 2; ++k) dst[m][k] = *(const PG8_LAS bf16x8*)(lds + PG8_SA(b, h) + aoff + m * 2048 + k * 1024); } while (0)
#define PG8_LDB(dst, b, h) do { _Pragma("unroll") for (int n = 0; n < 2; ++n) _Pragma("unroll") for (int k = 0; k < 2; ++k) dst[n][k] = *(const PG8_LAS bf16x8*)(lds + PG8_SB(b, h) + boff + n * 2048 + k * 1024); } while (0)
#define PG8_MMA(ai, bj, At, Bt) do { __builtin_amdgcn_s_setprio(1); _Pragma("unroll") for (int m = 0; m < 4; ++m) _Pragma("unroll") for (int n = 0; n < 2; ++n) _Pragma("unroll") for (int k = 0; k < 2; ++k) \
        acc[ai][bj][m][n] = __builtin_amdgcn_mfma_f32_16x16x32_bf16(Bt[n][k], At[m][k], acc[ai][bj][m][n], 0, 0, 0); __builtin_amdgcn_s_setprio(0); } while (0)
#define PG8_WAIT_V(n) asm volatile("s_waitcnt vmcnt(" #n ")" ::: "memory")
#define PG8_WAIT_L(n) asm volatile("s_waitcnt lgkmcnt(" #n ")" ::: "memory")
#define PG8_BAR __builtin_amdgcn_s_barrier()
#define PG8_SCHED __builtin_amdgcn_sched_barrier(0)
    Unit cur, nxt; int ui = 0;
    if (!S.next(0, cur)) return;
    f32x4 acc[2][2][4][2];
#pragma unroll
    for (int a = 0; a < 2; ++a)
#pragma unroll
        for (int b = 0; b < 2; ++b)
#pragma unroll
            for (int m = 0; m < 4; ++m)
#pragma unroll
                for (int n = 0; n < 2; ++n) acc[a][b][m][n] = (f32x4){0.f, 0.f, 0.f, 0.f};
    bf16x8 At[4][2], B0[2][2], B1[2][2];
    const char* cA = (const char*)g.A + (size_t)cur.pm * tstep; const char* cB = (const char*)g.Bt + (size_t)cur.pn * tstep;
    S.a_ready(cur);
    if constexpr (SP2) {
        PG8_STAGE(PG8_SB(0, 0), cB, voffB); PG8_STAGE(PG8_SB(0, 1), cB + hstep, voffB); PG8_STAGE(PG8_SA(0, 0), cA, voffA); PG8_STAGE(PG8_SA(0, 1), cA + hstep, voffA);
        if (wr == 1) PG8_BAR;
        PG8_WAIT_V(2); PG8_BAR;
        PG8_STAGE(PG8_SB(1, 0), cB + kstep, voffB); PG8_STAGE(PG8_SA(1, 0), cA + kstep, voffA); PG8_STAGE(PG8_SB(1, 1), cB + hstep + kstep, voffB);
        PG8_WAIT_V(6); PG8_BAR;
    } else {
        PG8_STAGE(PG8_SB(0, 0), cB, voffB); PG8_STAGE(PG8_SA(0, 0), cA, voffA); PG8_STAGE(PG8_SB(0, 1), cB + hstep, voffB); PG8_STAGE(PG8_SA(0, 1), cA + hstep, voffA);
        if (wr == 1) PG8_BAR;
        PG8_WAIT_V(4); PG8_BAR;
        PG8_STAGE(PG8_SB(1, 0), cB + kstep, voffB); PG8_STAGE(PG8_SA(1, 0), cA + kstep, voffA); PG8_STAGE(PG8_SB(1, 1), cB + hstep + kstep, voffB);
        PG8_WAIT_V(6); PG8_BAR;
    }
    for (;;) {
        const bool has_next = S.next(ui + 1, nxt);
        const char* nA = has_next ? (const char*)g.A + (size_t)nxt.pm * tstep : cA; const char* nB = has_next ? (const char*)g.Bt + (size_t)nxt.pn * tstep : cB;
        for (int t = 0; t < nt; t += 2) {
            const bool last = (t == nt - 2);
            const char* a1 = cA + (size_t)(t + 1) * kstep;
            const char* a2 = last ? nA : cA + (size_t)(t + 2) * kstep; const char* b2 = last ? nB : cB + (size_t)(t + 2) * kstep;
            const char* a3 = a2 + kstep; const char* b3 = b2 + kstep;
            if (last && has_next) S.a_ready(nxt);
            if constexpr (SP2) {
            PG8_LDB(B0, 0, 0); PG8_LDB(B1, 0, 1); PG8_SCHED; PG8_LDA(At, 0, 0); PG8_STAGE(PG8_SA(1, 1), a1 + hstep, voffA);
            PG8_WAIT_V(8); PG8_WAIT_L(0); PG8_BAR; PG8_MMA(0, 0, At, B0); PG8_MMA(0, 1, At, B1); PG8_BAR; PG8_SCHED;
            PG8_LDA(At, 0, 1); PG8_STAGE(PG8_SB(0, 0), b2, voffB); PG8_STAGE(PG8_SB(0, 1), b2 + hstep, voffB); PG8_STAGE(PG8_SA(0, 0), a2, voffA);
            PG8_WAIT_V(8); PG8_WAIT_L(0); PG8_BAR; PG8_MMA(1, 0, At, B0); PG8_MMA(1, 1, At, B1); PG8_BAR; PG8_SCHED;
            PG8_LDB(B0, 1, 0); PG8_LDB(B1, 1, 1); PG8_SCHED; PG8_LDA(At, 1, 0); PG8_STAGE(PG8_SA(0, 1), a2 + hstep, voffA);
            PG8_WAIT_V(8); PG8_WAIT_L(0); PG8_BAR; PG8_MMA(0, 0, At, B0); PG8_MMA(0, 1, At, B1); PG8_BAR; PG8_SCHED;
            PG8_LDA(At, 1, 1); PG8_STAGE(PG8_SB(1, 0), b3, voffB); PG8_STAGE(PG8_SB(1, 1), b3 + hstep, voffB); PG8_STAGE(PG8_SA(1, 0), a3, voffA);
            PG8_WAIT_V(8); PG8_WAIT_L(0); PG8_BAR; PG8_MMA(1, 0, At, B0); PG8_MMA(1, 1, At, B1); PG8_BAR; PG8_SCHED;
            } else {
            PG8_LDB(B0, 0, 0); PG8_SCHED; PG8_LDA(At, 0, 0); PG8_STAGE(PG8_SA(1, 1), a1 + hstep, voffA);
            PG8_WAIT_L(8); PG8_BAR; PG8_WAIT_L(0); PG8_MMA(0, 0, At, B0); PG8_BAR; PG8_SCHED;
            PG8_LDB(B1, 0, 1); PG8_STAGE(PG8_SB(0, 0), b2, voffB);
            PG8_BAR; PG8_WAIT_L(0); PG8_MMA(0, 1, At, B1); PG8_BAR;
            PG8_LDA(At, 0, 1); PG8_STAGE(PG8_SA(0, 0), a2, voffA);
            PG8_BAR; PG8_WAIT_L(0); PG8_MMA(1, 0, At, B0); PG8_BAR; PG8_SCHED;
            PG8_STAGE(PG8_SB(0, 1), b2 + hstep, voffB);
            PG8_WAIT_V(6); PG8_BAR; PG8_MMA(1, 1, At, B1); PG8_BAR;
            PG8_LDB(B0, 1, 0); PG8_SCHED; PG8_LDA(At, 1, 0); PG8_STAGE(PG8_SA(0, 1), a2 + hstep, voffA);
            PG8_WAIT_L(8); PG8_BAR; PG8_WAIT_L(0); PG8_MMA(0, 0, At, B0); PG8_BAR; PG8_SCHED;
            PG8_LDB(B1, 1, 1); PG8_STAGE(PG8_SB(1, 0), b3, voffB);
            PG8_BAR; PG8_WAIT_L(0); PG8_MMA(0, 1, At, B1); PG8_BAR;
            PG8_LDA(At, 1, 1); PG8_STAGE(PG8_SA(1, 0), a3, voffA);
            PG8_BAR; PG8_WAIT_L(0); PG8_MMA(1, 0, At, B0); PG8_BAR; PG8_SCHED;
            PG8_STAGE(PG8_SB(1, 1), b3 + hstep, voffB);
            PG8_WAIT_V(6); PG8_BAR; PG8_MMA(1, 1, At, B1); PG8_BAR;
            }
        }
        if constexpr (ALIGN_EPI) { if (wr == 0) PG8_BAR; }
        if constexpr (!Epi::AFTER_DRAIN) { E(acc, cur, wr, wc, fr, fq); S.done(cur); }
        if (!has_next) break;
#pragma unroll
        for (int a = 0; a < 2; ++a)
#pragma unroll
            for (int b = 0; b < 2; ++b)
#pragma unroll
                for (int m = 0; m < 4; ++m)
#pragma unroll
                    for (int n = 0; n < 2; ++n) acc[a][b][m][n] = (f32x4){0.f, 0.f, 0.f, 0.f};
        cur = nxt; cA = nA; cB = nB; ++ui;
        if constexpr (ALIGN_EPI) { if (wr == 1) PG8_BAR; }
    }
    PG8_WAIT_V(0);
    if constexpr (!ALIGN_EPI) { if (wr == 0) PG8_BAR; }
    PG8_BAR;
    if constexpr (Epi::AFTER_DRAIN) { E.fused(acc, cur, wr, wc, fr, fq, lds, wid, lane); S.done(cur); }
#undef PG8_SA
#undef PG8_SB
#undef PG8_STAGE
#undef PG8_LDA
#undef PG8_LDB
#undef PG8_MMA
#undef PG8_WAIT_V
#undef PG8_WAIT_L
#undef PG8_BAR
#undef PG8_SCHED
}
}
namespace pg8 {
typedef unsigned u32x2 __attribute__((ext_vector_type(2)));
__device__ __forceinline__ float bf2f(unsigned b16) { return __uint_as_float(b16 << 16); }
__device__ __forceinline__ float bflo(unsigned w) { return __uint_as_float(w << 16); }
__device__ __forceinline__ float bfhi(unsigned w) { return __uint_as_float(w & 0xffff0000u); }
__device__ __forceinline__ float h2f(unsigned h16) { return (float)__builtin_bit_cast(_Float16, (unsigned short)h16); }
__device__ __forceinline__ float rstd_of(const float* ssq, int row) { const f32x4* p = (const f32x4*)(ssq + (size_t)row * 16); const f32x4 a = p[0], b = p[1], c = p[2], d = p[3];
    const float s = ((a[0] + a[1]) + (a[2] + a[3])) + ((b[0] + b[1]) + (b[2] + b[3])) + ((c[0] + c[1]) + (c[2] + c[3])) + ((d[0] + d[1]) + (d[2] + d[3])); return 1.0f / sqrtf(s * (1.0f / 1024.0f) + 1e-6f); }
__device__ __forceinline__ float shx(float v, int mask, int lane) { return __int_as_float(__builtin_amdgcn_ds_bpermute((lane ^ mask) << 2, __float_as_int(v))); }
__device__ __forceinline__ float silu_f(float x) { return x * __builtin_amdgcn_rcpf(1.0f + __builtin_amdgcn_exp2f(-1.4426950408889634f * x)); }
__device__ __forceinline__ u32x4 pack8(const f32x4& a, const f32x4& b) { u32x4 w; w.x = cvt_pk_bf16(a[0], a[1]); w.y = cvt_pk_bf16(a[2], a[3]); w.z = cvt_pk_bf16(b[0], b[1]); w.w = cvt_pk_bf16(b[2], b[3]); return w; }

struct EpiRetQKV {
    static constexpr bool PERM = true, AFTER_DRAIN = false;
    bf16_t *q, *k, *v; const float* ssq; const unsigned* rope;
    __device__ __forceinline__ void operator()(const f32x4 (&acc)[2][2][4][2], const Unit& u, int wr, int wc, int fr, int fq) const {
        const int t = u.pn; bf16_t* base; int ldc, colt;
        if (t < 4) { base = q; ldc = 1024; colt = t * 256; } else if (t < 8) { base = k; ldc = 1024; colt = (t - 4) * 256; } else { base = v; ldc = 2048; colt = (t - 8) * 256; }
        const bool rp = t < 8;
        const float lg2 = __builtin_amdgcn_logf(1.0f - __builtin_amdgcn_exp2f(-5.0f - (float)(t & 3)));
        const int row0 = u.pm * BM + wr * 64 + fr, d0 = wc * 32 + 8 * fq, col0 = colt + d0;
#pragma unroll
        for (int ai = 0; ai < 2; ++ai)
#pragma unroll
            for (int m = 0; m < 4; ++m) {
                const int row = row0 + ai * HALF + m * 16; const float rs = rstd_of(ssq, row);
                f32x4 v0[2], v1[2];
#pragma unroll
                for (int n = 0; n < 2; ++n) { v0[n] = acc[ai][0][m][n] * rs; v1[n] = acc[ai][1][m][n] * rs; }
                if (rp) {
                    const float dsc = __builtin_amdgcn_exp2f((t < 4 ? lg2 : -lg2) * (float)((row & 255) + 1));
#pragma unroll
                    for (int n = 0; n < 2; ++n) { const u32x4 cs = *(const u32x4*)(rope + (size_t)row * 128 + d0 + 4 * n);
#pragma unroll
                        for (int e = 0; e < 4; ++e) { const float c = h2f(cs[e] & 0xffffu) * dsc, s = h2f(cs[e] >> 16) * dsc, a = v0[n][e], b = v1[n][e]; v0[n][e] = a * c - b * s; v1[n][e] = b * c + a * s; } }
                }
                bf16_t* rowp = base + (size_t)row * ldc + col0;
                *(u32x4*)(rowp) = pack8(v0[0], v0[1]); *(u32x4*)(rowp + HALF) = pack8(v1[0], v1[1]);
            }
    }
};

struct EpiGate {
    static constexpr bool PERM = true, AFTER_DRAIN = false;
    bf16_t* O; const float* ssq;
    __device__ __forceinline__ void operator()(const f32x4 (&acc)[2][2][4][2], const Unit& u, int wr, int wc, int fr, int fq) const {
        const int row0 = u.pm * BM + wr * 64 + fr, col0 = u.pn * BM + wc * 32 + 8 * fq;
#pragma unroll
        for (int ai = 0; ai < 2; ++ai)
#pragma unroll
            for (int m = 0; m < 4; ++m) {
                const int row = row0 + ai * HALF + m * 16; const float rs = rstd_of(ssq, row);
#pragma unroll
                for (int bj = 0; bj < 2; ++bj) { bf16_t* p = O + (size_t)row * 2048 + col0 + bj * HALF; const u32x4 ov = *(const u32x4*)p; f32x4 r[2];
#pragma unroll
                    for (int n = 0; n < 2; ++n)
#pragma unroll
                        for (int e = 0; e < 4; ++e) { const unsigned w = ov[2 * n + (e >> 1)]; const float o = (e & 1) ? bfhi(w) : bflo(w); r[n][e] = o * silu_f(acc[ai][bj][m][n][e] * rs); }
                    *(u32x4*)p = pack8(r[0], r[1]); }
            }
    }
};

struct EpiSwiGLU {
    static constexpr bool PERM = true, AFTER_DRAIN = false;
    bf16_t* Hb; const float* ssq;
    __device__ __forceinline__ void operator()(const f32x4 (&acc)[2][2][4][2], const Unit& u, int wr, int wc, int fr, int fq) const {
        const int row0 = u.pm * BM + wr * 64 + fr, col0 = u.pn * HALF + wc * 32 + 8 * fq;
#pragma unroll
        for (int ai = 0; ai < 2; ++ai)
#pragma unroll
            for (int m = 0; m < 4; ++m) {
                const int row = row0 + ai * HALF + m * 16; const float rs = rstd_of(ssq, row); f32x4 r[2];
#pragma unroll
                for (int n = 0; n < 2; ++n)
#pragma unroll
                    for (int e = 0; e < 4; ++e) r[n][e] = silu_f(acc[ai][0][m][n][e] * rs) * (acc[ai][1][m][n][e] * rs);
                *(u32x4*)(Hb + (size_t)row * 2816 + col0) = pack8(r[0], r[1]);
            }
    }
};

struct EpiLruIn {
    static constexpr bool PERM = true, AFTER_DRAIN = false;
    bf16_t *gate, *uraw; const float* ssq;
    __device__ __forceinline__ void operator()(const f32x4 (&acc)[2][2][4][2], const Unit& u, int wr, int wc, int fr, int fq) const {
        const int t = u.pn; bf16_t* base = t < 6 ? gate : uraw; const int colt = (t < 6 ? t : t - 6) * 256;
        const int row0 = u.pm * BM + wr * 64 + fr, col0 = colt + wc * 32 + 8 * fq;
#pragma unroll
        for (int ai = 0; ai < 2; ++ai)
#pragma unroll
            for (int m = 0; m < 4; ++m) {
                const int row = row0 + ai * HALF + m * 16; const float rs = rstd_of(ssq, row);
                bf16_t* rowp = base + (size_t)row * 1536 + col0;
#pragma unroll
                for (int bj = 0; bj < 2; ++bj) *(u32x4*)(rowp + bj * HALF) = pack8(acc[ai][bj][m][0] * rs, acc[ai][bj][m][1] * rs);
            }
    }
};

struct EpiSwaQKV {
    static constexpr bool PERM = true, AFTER_DRAIN = false;
    bf16_t *q, *k, *v; const float* ssq; const unsigned* rope; const float* bias;
    __device__ __forceinline__ void operator()(const f32x4 (&acc)[2][2][4][2], const Unit& u, int wr, int wc, int fr, int fq) const {
        const int t = u.pn; bf16_t* base; int ldc, colt; float sc = 1.0f;
        if (t < 4) { base = q; ldc = 1024; colt = t * 256; sc = 0.125f; } else if (t == 4) { base = k; ldc = 256; colt = 0; } else { base = v; ldc = 256; colt = 0; }
        const bool rp = t < 5;
        const int row0 = u.pm * BM + wr * 64 + fr, d0 = 8 * fq, ncol0 = 64 * wc + 8 * fq;
#pragma unroll
        for (int ai = 0; ai < 2; ++ai)
#pragma unroll
            for (int m = 0; m < 4; ++m) {
                asm volatile("" ::: "memory");
                const int row = row0 + ai * HALF + m * 16; const float rs = rstd_of(ssq, row);
                f32x4 v0[2], v1[2];
#pragma unroll
                for (int n = 0; n < 2; ++n) { v0[n] = acc[ai][0][m][n] * rs + *(const f32x4*)(bias + t * 256 + ncol0 + 4 * n); v1[n] = acc[ai][1][m][n] * rs + *(const f32x4*)(bias + t * 256 + ncol0 + 32 + 4 * n); }
                if (rp) {
#pragma unroll
                    for (int n = 0; n < 2; ++n) { const u32x4 cs = *(const u32x4*)(rope + (size_t)row * 32 + d0 + 4 * n);
#pragma unroll
                        for (int e = 0; e < 4; ++e) { const float c = h2f(cs[e] & 0xffffu), s = h2f(cs[e] >> 16), a = v0[n][e], b = v1[n][e]; v0[n][e] = (a * c - b * s) * sc; v1[n][e] = (b * c + a * s) * sc; } }
                }
                bf16_t* rowp = base + (size_t)row * ldc + colt + ncol0;
                *(u32x4*)(rowp) = pack8(v0[0], v0[1]); *(u32x4*)(rowp + 32) = pack8(v1[0], v1[1]);
            }
    }
};

struct EpiRes {
    static constexpr bool PERM = false, AFTER_DRAIN = false;
    const float* base; float* out; bf16_t* xn; float* ssq; const float* bias;
    __device__ __forceinline__ void operator()(const f32x4 (&acc)[2][2][4][2], const Unit& u, int wr, int wc, int fr, int fq) const {
        const int col0 = u.pn * BM + wc * 32 + 4 * fq;
        f32x4 bv[2][2];
#pragma unroll
        for (int bj = 0; bj < 2; ++bj)
#pragma unroll
            for (int n = 0; n < 2; ++n) bv[bj][n] = bias ? *(const f32x4*)(bias + col0 + bj * HALF + n * 16) : (f32x4){0.f, 0.f, 0.f, 0.f};
#pragma unroll
        for (int ai = 0; ai < 2; ++ai)
#pragma unroll
            for (int m = 0; m < 4; ++m) {
                const int row = u.pm * BM + ai * HALF + wr * 64 + m * 16 + fr; const size_t off = (size_t)row * 1024 + col0; float s = 0.f;
#pragma unroll
                for (int bj = 0; bj < 2; ++bj)
#pragma unroll
                    for (int n = 0; n < 2; ++n) { const f32x4 b = *(const f32x4*)(base + off + bj * HALF + n * 16); const f32x4 x = acc[ai][bj][m][n] + b + bv[bj][n];
                        *(f32x4*)(out + off + bj * HALF + n * 16) = x; u32x2 w; w.x = cvt_pk_bf16(x[0], x[1]); w.y = cvt_pk_bf16(x[2], x[3]); *(u32x2*)(xn + off + bj * HALF + n * 16) = w;
                        s += (x[0] * x[0] + x[1] * x[1]) + (x[2] * x[2] + x[3] * x[3]); }
                s += shx(s, 16, fq * 16 + fr); s += shx(s, 32, fq * 16 + fr);
                if (fq == 0) ssq[(size_t)row * 16 + u.pn * 4 + wc] = s;
            }
    }
};
}
#define GAS __attribute__((address_space(1)))
#define LAS __attribute__((address_space(3)))
typedef unsigned short bf16;
typedef unsigned v4u __attribute__((ext_vector_type(4)));
typedef float f32x4 __attribute__((ext_vector_type(4)));
typedef short bf16x8 __attribute__((ext_vector_type(8)));
typedef GAS unsigned gu32;
typedef GAS unsigned long long gu64;
#define RLX_AGENT __ATOMIC_RELAXED, __HIP_MEMORY_SCOPE_AGENT
#define LDS_WAIT() asm volatile("s_waitcnt lgkmcnt(0)" ::: "memory")
#define VM_WAIT() asm volatile("s_waitcnt vmcnt(0)" ::: "memory")
__device__ __forceinline__ unsigned long long rt() { return __builtin_amdgcn_s_memrealtime(); }
__device__ __forceinline__ unsigned f2bf(float f) { unsigned u = __builtin_bit_cast(unsigned, f); return (u + 0x7fffu + ((u >> 16) & 1u)) >> 16; }
__device__ __forceinline__ unsigned pk2(float lo, float hi) { return f2bf(lo) | (f2bf(hi) << 16); }

#define XB_TMO      128
#define XB_XCNT(j)  (256  + 64 * (j))
#define XB_XSUB(j)  (1280 + 64 * (j))
#define XB_XGEN(j)  (2304 + 64 * (j))
#define XB_TOP      3328
#define XB_TOPGEN   3392
#define XCD_BAR_WORDS 3456
#define XB_SPIN_CAP (1u << 18)

__device__ __forceinline__ unsigned xb_ld(unsigned* p)              { return __hip_atomic_load(p, __ATOMIC_RELAXED, __HIP_MEMORY_SCOPE_AGENT); }
__device__ __forceinline__ unsigned xb_add(unsigned* p, unsigned v) { return __hip_atomic_fetch_add(p, v, __ATOMIC_RELAXED, __HIP_MEMORY_SCOPE_AGENT); }
__device__ __forceinline__ unsigned xb_xcc_id() { return (unsigned)__builtin_amdgcn_s_getreg((3 << 11) | 20) & 0xFu; }
#define XB_SPIN(cond, bar) do { unsigned _sp = 0; while (cond) { __builtin_amdgcn_s_sleep(1); \
    if ((++_sp & 255u) == 0u) { if (xb_ld(&(bar)[XB_TMO])) break; if (_sp > XB_SPIN_CAP) { atomicAdd(&(bar)[XB_TMO], 1u); break; } } } } while (0)

struct XcdBarrier {
    unsigned* bar; unsigned x;
    volatile LAS unsigned* st;
};

__device__ __forceinline__ XcdBarrier xcd_barrier_post(unsigned* bar, volatile LAS unsigned* st) {
    XcdBarrier b; b.bar = bar; b.x = xb_xcc_id(); b.st = st;
    if (threadIdx.x == 0) (void)xb_add(&bar[XB_XCNT(b.x)], 1u);
    return b;
}
__device__ __forceinline__ void xcd_barrier_complete(unsigned* bar, unsigned x, unsigned& nloc, unsigned& nx) {
    const unsigned G = gridDim.x * gridDim.y * gridDim.z;
    unsigned sum, cnt, mine, sp = 0u;
    for (;;) {
        sum = 0u; cnt = 0u; mine = 0u;
#pragma unroll
        for (unsigned j = 0; j < 16; ++j) { const unsigned c = xb_ld(&bar[XB_XCNT(j)]); sum += c; cnt += (c > 0u) ? 1u : 0u; mine = (j == x) ? c : mine; }
        if (sum == G) break;
        __builtin_amdgcn_s_sleep(1);
        if ((++sp & 255u) == 0u) { if (xb_ld(&bar[XB_TMO])) break; if (sp > XB_SPIN_CAP) { atomicAdd(&bar[XB_TMO], 1u); break; } }
    }
    nloc = mine > 0u ? mine : 1u; nx = cnt > 0u ? cnt : 1u;
}

__device__ __forceinline__ void xcd_barrier(const XcdBarrier& b) {
    asm volatile("s_waitcnt vmcnt(0)" ::: "memory");
    __syncthreads();
    if (threadIdx.x == 0) {
        unsigned* bar = b.bar;
        __builtin_amdgcn_s_waitcnt(0);
        unsigned nloc = b.st[0], nx = b.st[1];
        if (nloc == 0u) { xcd_barrier_complete(bar, b.x, nloc, nx); b.st[0] = nloc; b.st[1] = nx; }
        const unsigned old = xb_add(&bar[XB_XSUB(b.x)], 1u);
        const unsigned gen = old / nloc;
        if (old + 1u == (gen + 1u) * nloc) {
            __builtin_amdgcn_fence(__ATOMIC_RELEASE, "agent");
            asm volatile("s_waitcnt vmcnt(0)" ::: "memory");
            const unsigned og = xb_add(&bar[XB_TOP], 1u);
            const unsigned tg = og / nx;
            if (og + 1u == (tg + 1u) * nx) xb_add(&bar[XB_TOPGEN], 1u);
            else XB_SPIN(xb_ld(&bar[XB_TOPGEN]) == tg, bar);
            __builtin_amdgcn_fence(__ATOMIC_ACQUIRE, "agent");
            xb_add(&bar[XB_XGEN(b.x)], 1u);
            asm volatile("s_waitcnt vmcnt(0)" ::: "memory");
        } else {
            XB_SPIN(xb_ld(&bar[XB_XGEN(b.x)]) == gen, bar);
            __builtin_amdgcn_fence(__ATOMIC_ACQUIRE, "agent");
            asm volatile("s_waitcnt vmcnt(0)" ::: "memory");
        }
    }
    __syncthreads();
}
constexpr int NWAVES = 8;
constexpr int BATCH = 8, SEQ = 2048, DM = 1024, M = BATCH * SEQ, DEPTH = 4;
constexpr int RET_H = 4, RET_DK = 256, RET_DV = 512, RET_C = 128;
constexpr int LRU_W = 1536, LRU_NB = 8, LRU_BW = 192;
constexpr int SWA_DH = 64, SWA_HQ = 16, SWA_HKV = 4, SWA_WIN = 128;
constexpr int FFN_H = 2816;
constexpr int N_IN = 23;
enum In { I_X = 0, I_POS, I_MIXN, I_FFNN, I_FINN, I_RET_WIN, I_RET_WOUT, I_LRU_WIN, I_LRU_CW, I_LRU_CB, I_LRU_WR, I_LRU_BR, I_LRU_WI, I_LRU_BI, I_LRU_LAM, I_LRU_WOUT,
          I_SWA_WQKV, I_SWA_BQKV, I_SWA_SINK, I_SWA_WOUT, I_SWA_BOUT, I_FFN_WGU, I_FFN_WDN };

constexpr size_t MiB = 1u << 20;
constexpr size_t WS_CTL = 0, CTL_ZERO_BYTES = 64 * 1024;
constexpr size_t WS_SSQ = 1 * MiB;
constexpr size_t WS_W = 3 * MiB;
constexpr size_t WO_RETIN = 0, WO_RETOUT = 12582912, WO_LRUIN = 16777216, WO_LRUOUT = 19922944, WO_SWAQKV = 21495808, WO_SWAOUT = 23068672, WO_FFNGU = 24117248, WO_FFNDN = 47185920, WO_END = 58720256;
constexpr size_t WS_ROPEA = 115 * MiB, WS_ROPEB = 123 * MiB, WS_XN = 125 * MiB, WS_ACT = 157 * MiB, WS_END = 349 * MiB;
static_assert(WS_W + WO_END * 2 <= WS_ROPEA, "weights fit");
constexpr size_t A_RQ = 0, A_RK = 32 * MiB, A_RV = 64 * MiB, A_RO = 128 * MiB;
constexpr size_t A_H = 0;
constexpr size_t A_LG = 0, A_LU = 48 * MiB, A_LUC = 96 * MiB, A_LY = 144 * MiB;
constexpr size_t A_SQ = 0, A_SK = 32 * MiB, A_SV = 40 * MiB, A_SO = 48 * MiB;
constexpr int CW_BAR = 1024;

constexpr int RING_BYTES = 131072;
constexpr int LDS_BYTES = 163840;
constexpr int LDSCTL_OFF = LDS_BYTES - 1024, MISC_OFF = LDSCTL_OFF + 320;
constexpr int LDS_AUX_OFF = RING_BYTES + 1024;

struct Args { const void* in[N_IN]; float* out; unsigned char* ws; int ph_lo, ph_hi, li, pad; };
typedef const __attribute__((address_space(4))) Args* CArgs;
struct Frame {
    LAS unsigned char* lds;
    volatile LAS unsigned* MISC;
    gu32* ctl;
    int tid, lane, wave, G, bx;
    CArgs ap;
    unsigned char* ws;
};
__device__ __forceinline__ const float* inF(const Frame& F, int i) { return (const float*)F.ap->in[i]; }
__device__ __forceinline__ bf16* wsW(const Frame& F, size_t eoff) { return (bf16*)(F.ws + WS_W) + eoff; }
__device__ __forceinline__ bf16* wsA(const Frame& F, size_t boff) { return (bf16*)(F.ws + WS_ACT + boff); }
__device__ __forceinline__ float* wsSSQ(const Frame& F, int idx) { return (float*)(F.ws + WS_SSQ) + (size_t)(idx & 1) * M * 16; }
__device__ __forceinline__ float bf2f(unsigned b16) { return __uint_as_float(b16 << 16); }
__device__ __forceinline__ float bflo(unsigned w) { return __uint_as_float(w << 16); }
__device__ __forceinline__ float bfhi(unsigned w) { return __uint_as_float(w & 0xffff0000u); }

__device__ __forceinline__ float shx(float v, int mask, int lane) { return __int_as_float(__builtin_amdgcn_ds_bpermute((lane ^ mask) << 2, __float_as_int(v))); }
__device__ __forceinline__ float wave_sum(float v, int lane) {
#pragma unroll
    for (int o = 1; o < 64; o <<= 1) v += shx(v, o, lane);
    return v;
}
__device__ __forceinline__ float wave_max(float v, int lane) {
#pragma unroll
    for (int o = 1; o < 64; o <<= 1) v = fmaxf(v, shx(v, o, lane));
    return v;
}

struct Job { const float* W; bf16* WT; const float* gain; int K, Npitch, Nd, map; };
constexpr int NJOBS = 16;
__host__ __device__ constexpr int job_items(int j) {
    return j < 2 ? (1024 / 128) * (6144 / 128) : j < 4 ? (2048 / 128) * (1024 / 128) : j == 4 ? (1024 / 128) * (3072 / 128) : j == 5 ? (1536 / 128) * (1024 / 128) : j == 6 ? (1024 / 128) * (1536 / 128)
         : j == 7 ? (1024 / 128) * (1024 / 128) : j < 12 ? (1024 / 128) * (5632 / 128) : (2816 / 128) * (1024 / 128);
}
__host__ __device__ constexpr int job_items_total() { int s = 0; for (int j = 0; j < NJOBS; ++j) s += job_items(j); return s; }
__device__ __forceinline__ void get_job(const Frame& F, int j, Job& J) {
    if (j < 2)       { J.W = inF(F, I_RET_WIN) + (size_t)j * 1024 * 6144; J.WT = wsW(F, WO_RETIN + (size_t)j * 6144 * 1024); J.gain = inF(F, I_MIXN) + (j == 0 ? 0 : 3) * 1024; J.K = 1024; J.Npitch = 6144; J.Nd = 6144; J.map = 1; }
    else if (j < 4)  { const int q = j - 2; J.W = inF(F, I_RET_WOUT) + (size_t)q * 2048 * 1024; J.WT = wsW(F, WO_RETOUT + (size_t)q * 1024 * 2048); J.gain = nullptr; J.K = 2048; J.Npitch = 1024; J.Nd = 1024; J.map = 0; }
    else if (j == 4) { J.W = inF(F, I_LRU_WIN); J.WT = wsW(F, WO_LRUIN); J.gain = inF(F, I_MIXN) + 1 * 1024; J.K = 1024; J.Npitch = 3072; J.Nd = 3072; J.map = 0; }
    else if (j == 5) { J.W = inF(F, I_LRU_WOUT); J.WT = wsW(F, WO_LRUOUT); J.gain = nullptr; J.K = 1536; J.Npitch = 1024; J.Nd = 1024; J.map = 0; }
    else if (j == 6) { J.W = inF(F, I_SWA_WQKV); J.WT = wsW(F, WO_SWAQKV); J.gain = inF(F, I_MIXN) + 2 * 1024; J.K = 1024; J.Npitch = 1536; J.Nd = 1536; J.map = 3; }
    else if (j == 7) { J.W = inF(F, I_SWA_WOUT); J.WT = wsW(F, WO_SWAOUT); J.gain = nullptr; J.K = 1024; J.Npitch = 1024; J.Nd = 1024; J.map = 0; }
    else if (j < 12) { const int l = j - 8; J.W = inF(F, I_FFN_WGU) + (size_t)l * 1024 * 5632; J.WT = wsW(F, WO_FFNGU + (size_t)l * 5632 * 1024); J.gain = inF(F, I_FFNN) + l * 1024; J.K = 1024; J.Npitch = 5632; J.Nd = 5632; J.map = 2; }
    else             { const int l = j - 12; J.W = inF(F, I_FFN_WDN) + (size_t)l * 2816 * 1024; J.WT = wsW(F, WO_FFNDN + (size_t)l * 1024 * 2816); J.gain = nullptr; J.K = 2816; J.Npitch = 1024; J.Nd = 1024; J.map = 0; }
}
__device__ __forceinline__ int src_col(int map, int nd) {
    if (map == 2) { const int pn = nd >> 8, p = nd & 255; return p < 128 ? 128 * pn + p : FFN_H + 128 * pn + (p - 128); }
    if (map == 3) { const int t = nd >> 8, p = nd & 255; return 256 * t + 64 * ((p & 127) >> 5) + 32 * (p >> 7) + (p & 31); }
    return nd;
}
struct TileRef { const float* src; bf16* dst; const float* gain; int Npitch, K; float cs; };
__device__ __forceinline__ void p0_tile_ref(const Frame& F, int tile, int tid, TileRef& T, int& ok) {
    int r = tile, j = 0;
    for (; j < NJOBS - 1; ++j) { const int n = job_items(j); if (r < n) break; r -= n; }
    Job J; get_job(F, j, J);
    const int nblk = J.Nd / 128, kb = r / nblk, nb = r % nblk, k0 = 128 * kb, nd0 = 128 * nb;
    const int nl = 4 * (tid & 31), ns = src_col(J.map, nd0 + (nl & ~31)) + (nl & 31);
    T.src = J.W + (size_t)(k0 + 8 * (tid >> 5)) * J.Npitch + ns; T.Npitch = J.Npitch; T.K = J.K;
    T.dst = J.WT + (size_t)nd0 * J.K + k0; T.gain = J.gain ? J.gain + k0 + 8 * (tid >> 5) : nullptr;
    T.cs = (J.map == 1 && nd0 >= 1024 && nd0 < 2048) ? 0.0625f : 1.0f; ok = 1;
}
__device__ __forceinline__ unsigned pack_cs(float ang) {
    const float n = rintf(ang * 0.15915494309189535f);
    float r = fmaf(-n, 6.28125f, ang); r = fmaf(-n, 1.9353071795864769e-3f, r);
    const float rev = r * 0.15915494309189535f;
    const float c = __builtin_amdgcn_cosf(rev), s = __builtin_amdgcn_sinf(rev);
    const unsigned short cb = __builtin_bit_cast(unsigned short, (_Float16)c), sb = __builtin_bit_cast(unsigned short, (_Float16)s);
    return (unsigned)cb | ((unsigned)sb << 16);
}
__device__ __forceinline__ void p0_prologue(Frame& F) {
    { int t_ = threadIdx.x; asm volatile("" : "+v"(t_)); F.tid = t_; F.lane = t_ & 63; F.wave = __builtin_amdgcn_readfirstlane(t_ >> 6); }
    const int gw = F.bx * NWAVES + F.wave, NGW = F.G * NWAVES;
    {
        constexpr int NTILES = job_items_total();
        LAS unsigned* Lt = (LAS unsigned*)F.lds;
        const int tid = F.tid;
        f32x4 va[8]; TileRef T; int ok = 0;
        int tile = F.bx;
        if (tile < NTILES) { p0_tile_ref(F, tile, tid, T, ok);
#pragma unroll
            for (int j = 0; j < 8; ++j) va[j] = *(const f32x4*)(T.src + (size_t)j * T.Npitch); }
        for (; tile < NTILES; tile += F.G) {
            float g[8];
#pragma unroll
            for (int j = 0; j < 8; ++j) g[j] = T.gain ? T.gain[j] * T.cs : T.cs;
            const int nl = 4 * (tid & 31), kg = tid >> 5;
#pragma unroll
            for (int e = 0; e < 4; ++e) { v4u wv_; wv_.x = pk2(va[0][e] * g[0], va[1][e] * g[1]); wv_.y = pk2(va[2][e] * g[2], va[3][e] * g[3]); wv_.z = pk2(va[4][e] * g[4], va[5][e] * g[5]); wv_.w = pk2(va[6][e] * g[6], va[7][e] * g[7]);
                *(LAS v4u*)(Lt + (nl + e) * 64 + 4 * (kg ^ ((tid & 31) & 15))) = wv_; }
            bf16* dst = T.dst; const int Kc = T.K;
            const int nxt = tile + F.G;
            if (nxt < NTILES) { p0_tile_ref(F, nxt, tid, T, ok);
#pragma unroll
                for (int j = 0; j < 8; ++j) va[j] = *(const f32x4*)(T.src + (size_t)j * T.Npitch); }
            __syncthreads();
#pragma unroll
            for (int i = 0; i < 4; ++i) { const int id = tid + 512 * i, n = id >> 4, c = id & 15;
                const v4u o = *(const LAS v4u*)(Lt + n * 64 + 4 * (c ^ ((n >> 2) & 15))); *(GAS v4u*)(dst + (size_t)n * Kc + 8 * c) = o; }
            __syncthreads();
        }
    }
    const int* pos = (const int*)F.ap->in[I_POS];
    unsigned* ropeA = (unsigned*)(F.ws + WS_ROPEA); unsigned* ropeB = (unsigned*)(F.ws + WS_ROPEB);
    const float* x = inF(F, I_X); bf16* xn = (bf16*)(F.ws + WS_XN); float* ssq0 = wsSSQ(F, 0);
    const float ifA0 = powf(10000.0f, -((float)F.lane * 2.0f / 256.0f)), ifA1 = powf(10000.0f, -((float)(F.lane + 64) * 2.0f / 256.0f)), ifB = powf(10000.0f, -((float)(F.lane & 31) * 2.0f / 64.0f));
    for (int m = gw; m < M; m += NGW) {
        const float p = (float)pos[m];
        ropeA[(size_t)m * 128 + F.lane] = pack_cs(p * ifA0); ropeA[(size_t)m * 128 + 64 + F.lane] = pack_cs(p * ifA1);
        if (F.lane < 32) ropeB[(size_t)m * 32 + F.lane] = pack_cs(p * ifB);
        const GAS f32x4* xr = (const GAS f32x4*)(x + (size_t)m * DM) + F.lane; f32x4 v[4]; float s = 0.f;
#pragma unroll
        for (int j = 0; j < 4; ++j) { v[j] = xr[64 * j]; s += (v[j].x * v[j].x + v[j].y * v[j].y) + (v[j].z * v[j].z + v[j].w * v[j].w); }
        s = wave_sum(s, F.lane); if (F.lane < 16) ssq0[(size_t)m * 16 + F.lane] = F.lane == 0 ? s : 0.f;
        GAS unsigned long long* o8 = (GAS unsigned long long*)(xn + (size_t)m * DM) + F.lane;
#pragma unroll
        for (int j = 0; j < 4; ++j) o8[64 * j] = (unsigned long long)pk2(v[j].x, v[j].y) | ((unsigned long long)pk2(v[j].z, v[j].w) << 32);
    }
}
__device__ __forceinline__ void final_norm(Frame& F) {
    { int t_ = threadIdx.x; asm volatile("" : "+v"(t_)); F.tid = t_; F.lane = t_ & 63; F.wave = __builtin_amdgcn_readfirstlane(t_ >> 6); }
    const int gw = F.bx * NWAVES + F.wave, NGW = F.G * NWAVES; const float* g = inF(F, I_FINN); float* out = F.ap->out;
    f32x4 gv[4];
#pragma unroll
    for (int j = 0; j < 4; ++j) gv[j] = ((const f32x4*)g)[F.lane + 64 * j];
    for (int m = gw; m < M; m += NGW) {
        GAS f32x4* xr = (GAS f32x4*)(out + (size_t)m * DM) + F.lane; f32x4 v[4]; float s = 0.f;
#pragma unroll
        for (int j = 0; j < 4; ++j) { v[j] = xr[64 * j]; s += (v[j].x * v[j].x + v[j].y * v[j].y) + (v[j].z * v[j].z + v[j].w * v[j].w); }
        const float rs = 1.0f / sqrtf(wave_sum(s, F.lane) * (1.0f / DM) + 1e-6f);
#pragma unroll
        for (int j = 0; j < 4; ++j) xr[64 * j] = v[j] * rs * gv[j];
    }
}

__device__ __forceinline__ void ret_core_naive(Frame& F) {
    { int t_ = threadIdx.x; asm volatile("" : "+v"(t_)); F.tid = t_; F.lane = t_ & 63; F.wave = __builtin_amdgcn_readfirstlane(t_ >> 6); }
    const int w = F.bx; if (w >= 256) return;
    const int b = w >> 5, h = (w >> 3) & 3, vs = w & 7, tid = F.tid;
    LAS float* S = (LAS float*)F.lds; LAS float* P = S + 256 * 64; LAS float* kdec = (LAS float*)(F.lds + LDS_AUX_OFF);
    const float lg = log1pf(-exp2f(-5.0f - (float)h));
    for (int i = tid; i < 256 * 64; i += 512) S[i] = 0.f;
    if (tid < 128) kdec[tid] = expf((float)(127 - tid) * lg);
    const float cdec = expf(128.0f * lg);
    __syncthreads();
    const bf16* Q = wsA(F, A_RQ); const bf16* K = wsA(F, A_RK); const bf16* V = wsA(F, A_RV); bf16* O = wsA(F, A_RO);
    for (int c = 0; c < SEQ / RET_C; ++c) {
        const size_t r0 = (size_t)b * SEQ + (size_t)c * RET_C;
        const bf16* qc = Q + r0 * 1024 + h * 256; const bf16* kc = K + r0 * 1024 + h * 256; const bf16* vc = V + r0 * 2048 + h * 512 + vs * 64; bf16* oc = O + r0 * 2048 + h * 512 + vs * 64;
        for (int idx = tid; idx < 128 * 128; idx += 512) {
            const int i = idx >> 7, j = idx & 127; float s = 0.f;
            if (j <= i) {
                const v4u* qp = (const v4u*)(qc + (size_t)i * 1024); const v4u* kp = (const v4u*)(kc + (size_t)j * 1024);
                for (int d8 = 0; d8 < 32; ++d8) { const v4u a = qp[d8], bb = kp[d8];
                    s += bflo(a.x) * bflo(bb.x) + bfhi(a.x) * bfhi(bb.x) + bflo(a.y) * bflo(bb.y) + bfhi(a.y) * bfhi(bb.y) + bflo(a.z) * bflo(bb.z) + bfhi(a.z) * bfhi(bb.z) + bflo(a.w) * bflo(bb.w) + bfhi(a.w) * bfhi(bb.w); }
                s *= expf((float)(i - j) * lg);
            }
            P[idx] = s;
        }
        __syncthreads();
        for (int idx = tid; idx < 128 * 64; idx += 512) {
            const int i = idx >> 6, vv = idx & 63; float inner = 0.f, cross = 0.f;
#pragma unroll 8
            for (int j = 0; j <= i; ++j) inner += P[i * 128 + j] * bf2f(vc[(size_t)j * 2048 + vv]);
#pragma unroll 8
            for (int d = 0; d < 256; ++d) cross += bf2f(qc[(size_t)i * 1024 + d]) * S[d * 64 + vv];
            oc[(size_t)i * 2048 + vv] = (bf16)f2bf(inner + cross * expf((float)(i + 1) * lg));
        }
        __syncthreads();
        for (int idx = tid; idx < 256 * 64; idx += 512) {
            const int d = idx >> 6, vv = idx & 63; float a = 0.f;
#pragma unroll 8
            for (int j = 0; j < 128; ++j) a += bf2f(kc[(size_t)j * 1024 + d]) * kdec[j] * bf2f(vc[(size_t)j * 2048 + vv]);
            S[idx] = S[idx] * cdec + a;
        }
        __syncthreads();
    }
}
__device__ __forceinline__ void ret_norm_naive(Frame& F) {
    { int t_ = threadIdx.x; asm volatile("" : "+v"(t_)); F.tid = t_; F.lane = t_ & 63; F.wave = __builtin_amdgcn_readfirstlane(t_ >> 6); }
    const int gw = F.bx * NWAVES + F.wave, NGW = F.G * NWAVES; bf16* V = wsA(F, A_RO);
    for (int it = gw; it < M * RET_H; it += NGW) {
        GAS v4u* p = (GAS v4u*)(V + (size_t)it * 512) + F.lane; const v4u a = *p;
        float f[8] = {bflo(a.x), bfhi(a.x), bflo(a.y), bfhi(a.y), bflo(a.z), bfhi(a.z), bflo(a.w), bfhi(a.w)}; float s = 0.f;
#pragma unroll
        for (int e = 0; e < 8; ++e) s += f[e] * f[e];
        const float rs = 1.0f / sqrtf(wave_sum(s, F.lane) * (1.0f / 512.0f) + 1e-6f);
        v4u o; o.x = pk2(f[0] * rs, f[1] * rs); o.y = pk2(f[2] * rs, f[3] * rs); o.z = pk2(f[4] * rs, f[5] * rs); o.w = pk2(f[6] * rs, f[7] * rs); *p = o;
    }
}
__device__ __forceinline__ void lru_conv_naive(Frame& F) {
    { int t_ = threadIdx.x; asm volatile("" : "+v"(t_)); F.tid = t_; F.lane = t_ & 63; F.wave = __builtin_amdgcn_readfirstlane(t_ >> 6); }
    const bf16* UR = wsA(F, A_LU); bf16* UC = wsA(F, A_LUC); const float* cw = inF(F, I_LRU_CW); const float* cb = inF(F, I_LRU_CB);
    const int gt = F.bx * 512 + F.tid, NGT = F.G * 512;
    for (int it = gt; it < M * (LRU_W / 8); it += NGT) {
        const int row = it / (LRU_W / 8), ch0 = (it % (LRU_W / 8)) * 8, t = row & (SEQ - 1); float a[8];
#pragma unroll
        for (int e = 0; e < 8; ++e) a[e] = cb[ch0 + e];
#pragma unroll
        for (int w = 0; w < 4; ++w) { if (t - 3 + w >= 0) { const v4u u = *(const v4u*)(UR + (size_t)(row - 3 + w) * LRU_W + ch0); const float* c = cw + w * LRU_W + ch0;
            a[0] += c[0] * bflo(u.x); a[1] += c[1] * bfhi(u.x); a[2] += c[2] * bflo(u.y); a[3] += c[3] * bfhi(u.y); a[4] += c[4] * bflo(u.z); a[5] += c[5] * bfhi(u.z); a[6] += c[6] * bflo(u.w); a[7] += c[7] * bfhi(u.w); } }
        v4u o; o.x = pk2(a[0], a[1]); o.y = pk2(a[2], a[3]); o.z = pk2(a[4], a[5]); o.w = pk2(a[6], a[7]); *(v4u*)(UC + (size_t)row * LRU_W + ch0) = o;
    }
}
__device__ __forceinline__ float gelu_tanh(float x) { const float u = 0.7978845608028654f * (x + 0.044715f * x * x * x); const float e = __expf(2.0f * u); const float th = 1.0f - 2.0f / (e + 1.0f); return 0.5f * x * (1.0f + th); }
__device__ __forceinline__ void lru_scan_naive(Frame& F) {
    { int t_ = threadIdx.x; asm volatile("" : "+v"(t_)); F.tid = t_; F.lane = t_ & 63; F.wave = __builtin_amdgcn_readfirstlane(t_ >> 6); }
    if (F.bx >= 192 || F.wave != 0) return;
    const int gid = F.bx * 64 + F.lane, b = gid / LRU_W, ch = gid % LRU_W, blk = ch / LRU_BW, dch = ch % LRU_BW;
    const bf16* G = wsA(F, A_LG); const bf16* UC = wsA(F, A_LUC); bf16* Y = wsA(F, A_LY);
    const float* wr = inF(F, I_LRU_WR) + (size_t)blk * LRU_BW * LRU_BW + dch; const float* wi = inF(F, I_LRU_WI) + (size_t)blk * LRU_BW * LRU_BW + dch;
    const float br = inF(F, I_LRU_BR)[ch], bi = inF(F, I_LRU_BI)[ch], lam = inF(F, I_LRU_LAM)[ch];
    const float sp = (lam > 0.f ? 0.f : -lam) + log1pf(expf(-fabsf(lam)));
    const float cneg = -8.0f * sp; float hst = 0.f;
    for (int t = 0; t < SEQ; ++t) {
        const size_t row = (size_t)b * SEQ + t; const bf16* up = UC + row * LRU_W + blk * LRU_BW; float ar = br, ai = bi;
#pragma unroll 16
        for (int c = 0; c < LRU_BW; ++c) { const float uu = bf2f(up[c]); ar += uu * wr[(size_t)c * LRU_BW]; ai += uu * wi[(size_t)c * LRU_BW]; }
        const float r = 1.0f / (1.0f + expf(-ar)), ig = 1.0f / (1.0f + expf(-ai));
        const float la = cneg * r, a = expf(la), bb = sqrtf(-expm1f(2.0f * la)) * (ig * bf2f(UC[row * LRU_W + ch]));
        hst = a * hst + bb;
        Y[row * LRU_W + ch] = (bf16)f2bf(hst * gelu_tanh(bf2f(G[row * LRU_W + ch])));
    }
}
__device__ __forceinline__ void swa_naive(Frame& F) {
    { int t_ = threadIdx.x; asm volatile("" : "+v"(t_)); F.tid = t_; F.lane = t_ & 63; F.wave = __builtin_amdgcn_readfirstlane(t_ >> 6); }
    const int gw = F.bx * NWAVES + F.wave, NGW = F.G * NWAVES, lane = F.lane;
    const bf16* Q = wsA(F, A_SQ); const bf16* K = wsA(F, A_SK); const bf16* V = wsA(F, A_SV); bf16* O = wsA(F, A_SO); const float* sinks = inF(F, I_SWA_SINK);
    LAS float* pl = (LAS float*)F.lds + F.wave * 128;
    for (int it = gw; it < M * SWA_HQ; it += NGW) {
        const int row = it >> 4, qh = it & 15, kvh = qh >> 2, t = row & (SEQ - 1);
        const v4u* qp = (const v4u*)(Q + (size_t)row * 1024 + qh * 64); v4u qv[8];
#pragma unroll
        for (int i = 0; i < 8; ++i) qv[i] = qp[i];
        float sc[2];
#pragma unroll
        for (int kk = 0; kk < 2; ++kk) {
            const int dj = 127 - lane - 64 * kk;
            float s = -INFINITY;
            if (t - dj >= 0) { const v4u* kp = (const v4u*)(K + (size_t)(row - dj) * 256 + kvh * 64); s = 0.f;
#pragma unroll
                for (int i = 0; i < 8; ++i) { const v4u a = qv[i], bb = kp[i];
                    s += bflo(a.x) * bflo(bb.x) + bfhi(a.x) * bfhi(bb.x) + bflo(a.y) * bflo(bb.y) + bfhi(a.y) * bfhi(bb.y) + bflo(a.z) * bflo(bb.z) + bfhi(a.z) * bfhi(bb.z) + bflo(a.w) * bflo(bb.w) + bfhi(a.w) * bfhi(bb.w); } }
            sc[kk] = s;
        }
        const float sk = sinks[qh];
        const float mx = fmaxf(wave_max(fmaxf(sc[0], sc[1]), F.lane), sk);
        const float p0 = expf(sc[0] - mx), p1 = expf(sc[1] - mx);
        const float den = wave_sum(p0 + p1, F.lane) + expf(sk - mx), inv = 1.0f / den;
        pl[127 - lane] = p0 * inv; pl[63 - lane] = p1 * inv;
        LDS_WAIT(); asm volatile("" ::: "memory");
        float o = 0.f; const int nk = t < 127 ? t + 1 : 128;
#pragma unroll 8
        for (int dj = 0; dj < nk; ++dj) o += pl[dj] * bf2f(V[(size_t)(row - dj) * 256 + kvh * 64 + lane]);
        O[(size_t)row * 1024 + qh * 64 + lane] = (bf16)f2bf(o);
        LDS_WAIT(); asm volatile("" ::: "memory");
    }
}
typedef short bf16x8v __attribute__((ext_vector_type(8)));
typedef float f32x4v __attribute__((ext_vector_type(4)));
__device__ __forceinline__ float sigmoid_f(float x) { return __builtin_amdgcn_rcpf(1.0f + __builtin_amdgcn_exp2f(-1.4426950408889634f * x)); }
__device__ __forceinline__ float gelu_fast(float x) { const float u = 2.302208198f * (x + 0.044715f * x * x * x);
    return x - x * __builtin_amdgcn_rcpf(__builtin_amdgcn_exp2f(u) + 1.0f); }
__device__ __forceinline__ void lru_fused(Frame& F) {
    { int t_ = threadIdx.x; asm volatile("" : "+v"(t_)); F.tid = t_; F.lane = t_ & 63; F.wave = __builtin_amdgcn_readfirstlane(t_ >> 6); }
    const int w = F.bx; if (w >= 256) return;
    const int b = w >> 5, blk = (w >> 2) & 7, cg = w & 3, tid = F.tid, lane = F.lane, wv = F.wave, fr = lane & 15, fq = lane >> 4;
    LAS unsigned short* U = (LAS unsigned short*)F.lds;
    LAS unsigned short* Rw = (LAS unsigned short*)(F.lds + 51200);
    LAS float* SA = (LAS float*)(F.lds + 51200);
    LAS float* SB = SA + 128 * 48;
    LAS float* GA = (LAS float*)(F.lds + 103600);
    LAS float* GB = GA + 8 * 48;
    LAS float* HC = GB + 8 * 48;
    LAS float* CW = HC + 2 * 48;
    LAS unsigned short* Wt = (LAS unsigned short*)(F.lds + 111616);
    const int chb = blk * LRU_BW, c0 = cg * 48;
    const bf16* UR = wsA(F, A_LU); const bf16* G = wsA(F, A_LG); bf16* Y = wsA(F, A_LY);
    {
        const float* wr = inF(F, I_LRU_WR) + (size_t)blk * LRU_BW * LRU_BW; const float* wi = inF(F, I_LRU_WI) + (size_t)blk * LRU_BW * LRU_BW;
        for (int id = tid; id < 96 * 192; id += 512) { const int k = id / 96, n = id % 96; const float v = (n < 48 ? wr : wi)[(size_t)k * LRU_BW + c0 + (n % 48)]; Wt[n * 200 + k] = (unsigned short)f2bf(v); }
        for (int id = tid; id < 5 * 192; id += 512) { const int r = id / 192, c = id % 192; CW[id] = r < 4 ? inF(F, I_LRU_CW)[r * LRU_W + chb + c] : inF(F, I_LRU_CB)[chb + c]; }
    }
    float br[3], bi[3], cn[3];
#pragma unroll
    for (int j = 0; j < 3; ++j) { const int gch = chb + c0 + 16 * j + fr; br[j] = inF(F, I_LRU_BR)[gch]; bi[j] = inF(F, I_LRU_BI)[gch]; const float lam = inF(F, I_LRU_LAM)[gch];
        cn[j] = -8.0f * 1.4426950408889634f * ((lam > 0.f ? 0.f : -lam) + log1pf(expf(-fabsf(lam)))); }
    const int sch = tid % 48, sg = tid / 48;
    if (tid < 96) HC[tid] = 0.f;
    v4u pre[7];
#define LRU_PREFETCH(seg_) do { const long rb = (long)b * SEQ + (long)(seg_) * 128 - 3; _Pragma("unroll") for (int i = 0; i < 7; ++i) { const int id = tid + 512 * i, row = id / 24, c8 = id % 24; \
        pre[i] = (v4u){0u, 0u, 0u, 0u}; if (id < 131 * 24 && ((seg_) > 0 || row >= 3)) pre[i] = *(const v4u*)(UR + (rb + row) * LRU_W + chb + c8 * 8); } } while (0)
    LRU_PREFETCH(0);
    for (int seg = 0; seg < SEQ / 128; ++seg) {
        const size_t row0 = (size_t)b * SEQ + (size_t)seg * 128;
#pragma unroll
        for (int i = 0; i < 7; ++i) { const int id = tid + 512 * i, row = id / 24, c8 = id % 24; if (id < 131 * 24) *(LAS v4u*)(Rw + row * 200 + c8 * 8) = pre[i]; }
        unsigned short gq[16];
        { const size_t gofs = (row0 + 16 * (tid < 384 ? sg : 0)) * LRU_W + chb + c0 + sch;
#pragma unroll
            for (int i = 0; i < 16; ++i) gq[i] = G[gofs + (size_t)i * LRU_W]; }
        __syncthreads();
        if (seg + 1 < SEQ / 128) LRU_PREFETCH(seg + 1);
#pragma unroll 2
        for (int i = 0; i < 6; ++i) {
            const int id = tid + 512 * i, token = id / 24, c8 = (id % 24) * 8; float a[8];
            { const f32x4v b0 = *(const LAS f32x4v*)(CW + 4 * 192 + c8), b1 = *(const LAS f32x4v*)(CW + 4 * 192 + c8 + 4); a[0] = b0[0]; a[1] = b0[1]; a[2] = b0[2]; a[3] = b0[3]; a[4] = b1[0]; a[5] = b1[1]; a[6] = b1[2]; a[7] = b1[3]; }
#pragma unroll
            for (int wq = 0; wq < 4; ++wq) { const v4u u = *(const LAS v4u*)(Rw + (token + wq) * 200 + c8);
                const f32x4v k0 = *(const LAS f32x4v*)(CW + wq * 192 + c8), k1 = *(const LAS f32x4v*)(CW + wq * 192 + c8 + 4);
                a[0] += k0[0] * bflo(u.x); a[1] += k0[1] * bfhi(u.x); a[2] += k0[2] * bflo(u.y); a[3] += k0[3] * bfhi(u.y); a[4] += k1[0] * bflo(u.z); a[5] += k1[1] * bfhi(u.z); a[6] += k1[2] * bflo(u.w); a[7] += k1[3] * bfhi(u.w); }
            v4u o; o.x = pk2(a[0], a[1]); o.y = pk2(a[2], a[3]); o.z = pk2(a[4], a[5]); o.w = pk2(a[6], a[7]);
            *(LAS v4u*)(U + token * 200 + c8) = o;
        }
        __syncthreads();
        f32x4v acc[6];
#pragma unroll
        for (int nt = 0; nt < 6; ++nt) acc[nt] = (f32x4v){0.f, 0.f, 0.f, 0.f};
#pragma unroll
        for (int ks = 0; ks < 6; ++ks) { const bf16x8v A = *(const LAS bf16x8v*)(U + (16 * wv + fr) * 200 + 32 * ks + 8 * fq);
#pragma unroll
            for (int nt = 0; nt < 6; ++nt) { const bf16x8v Bv = *(const LAS bf16x8v*)(Wt + (16 * nt + fr) * 200 + 32 * ks + 8 * fq); acc[nt] = __builtin_amdgcn_mfma_f32_16x16x32_bf16(A, Bv, acc[nt], 0, 0, 0); } }
#pragma unroll
        for (int j = 0; j < 3; ++j)
#pragma unroll
            for (int e = 0; e < 4; ++e) { const int token = 16 * wv + 4 * fq + e;
                const float r = sigmoid_f(acc[j][e] + br[j]), ig = sigmoid_f(acc[3 + j][e] + bi[j]), a = __builtin_amdgcn_exp2f(cn[j] * r);
                const float uval = bf2f(U[token * 200 + c0 + 16 * j + fr]);
                SA[token * 48 + 16 * j + fr] = a; SB[token * 48 + 16 * j + fr] = __builtin_amdgcn_sqrtf(fmaxf(1.0f - a * a, 0.f)) * (ig * uval); }
        __syncthreads();
        if (tid < 384) { float A = 1.f, B = 0.f;
#pragma unroll
            for (int i = 0; i < 16; ++i) { const int tk = 16 * sg + i; const float a = SA[tk * 48 + sch], bb = SB[tk * 48 + sch]; B = a * B + bb; A *= a; }
            GA[sg * 48 + sch] = A; GB[sg * 48 + sch] = B; }
        __syncthreads();
        if (tid < 384) { float h = HC[(seg & 1) * 48 + sch];
            for (int g = 0; g < sg; ++g) h = GA[g * 48 + sch] * h + GB[g * 48 + sch];
            const size_t gofs = (row0 + 16 * sg) * LRU_W + chb + c0 + sch;
#pragma unroll
            for (int i = 0; i < 16; ++i) { const int tk = 16 * sg + i; h = SA[tk * 48 + sch] * h + SB[tk * 48 + sch];
                Y[gofs + (size_t)i * LRU_W] = (bf16)f2bf(h * gelu_fast(bf2f(gq[i]))); }
            if (sg == 7) HC[((seg + 1) & 1) * 48 + sch] = h; }
        __syncthreads();
    }
#undef LRU_PREFETCH
}
typedef short v4s16 __attribute__((ext_vector_type(4)));
typedef unsigned u32x2v __attribute__((ext_vector_type(2)));
__device__ __forceinline__ v4s16 ds_tr16(const LAS unsigned short* p) { return __builtin_amdgcn_ds_read_tr16_b64_v4i16((LAS v4s16*)p); }
__device__ __forceinline__ bf16x8v frag_tr(const LAS unsigned short* X, int P, int k0, int c0, int lane) {
    const int g = lane >> 4, i = lane & 15, q = i >> 2, p = i & 3;
    const LAS unsigned short* a0 = X + (k0 + 8 * g + q) * P + c0 + 4 * p;
    const v4s16 lo = ds_tr16(a0), hi = ds_tr16(a0 + 4 * P);
    return (bf16x8v){lo[0], lo[1], lo[2], lo[3], hi[0], hi[1], hi[2], hi[3]};
}
constexpr size_t A_RS = 128 * MiB;
__device__ __forceinline__ void ret_state(Frame& F) {
    { int t_ = threadIdx.x; asm volatile("" : "+v"(t_)); F.tid = t_; F.lane = t_ & 63; F.wave = __builtin_amdgcn_readfirstlane(t_ >> 6); }
    const int w = F.bx; if (w >= 256) return;
    const int b = w >> 5, h = (w >> 3) & 3, vs = w & 7, tid = F.tid, lane = F.lane, wv = F.wave, fr = lane & 15, fq = lane >> 4;
    LAS unsigned short* Kt = (LAS unsigned short*)F.lds;
    LAS unsigned short* Vt = (LAS unsigned short*)(F.lds + 67584);
    const bf16* K = wsA(F, A_RK); const bf16* V = wsA(F, A_RV); bf16* ST = wsA(F, A_RS);
    const float cdec = exp2f(256.0f * log2f(1.0f - exp2f(-5.0f - (float)h)));
    f32x4v acc[2][4];
#pragma unroll
    for (int m = 0; m < 2; ++m)
#pragma unroll
        for (int n = 0; n < 4; ++n) acc[m][n] = (f32x4v){0.f, 0.f, 0.f, 0.f};
    v4u pk_[8], pv_[2];
#define RS_PREFETCH(step_) do { const size_t r0_ = (size_t)b * SEQ + (size_t)(step_) * 128; \
        _Pragma("unroll") for (int i = 0; i < 8; ++i) { const int id = tid + 512 * i, row = id >> 5, c16 = id & 31; pk_[i] = *(const v4u*)(K + (r0_ + row) * 1024 + h * 256 + c16 * 8); } \
        _Pragma("unroll") for (int i = 0; i < 2; ++i) { const int id = tid + 512 * i, row = id >> 3, c16 = id & 7; pv_[i] = *(const v4u*)(V + (r0_ + row) * 2048 + h * 512 + vs * 64 + c16 * 8); } } while (0)
    RS_PREFETCH(0);
    for (int blk = 0; blk < 8; ++blk) {
        if (blk > 0) {
            bf16* st = ST + ((size_t)((b * 4 + h) * 7 + (blk - 1)) * 512 + vs * 64) * 256;
#pragma unroll
            for (int m = 0; m < 2; ++m)
#pragma unroll
                for (int n = 0; n < 4; ++n) { u32x2v o; o.x = pk2(acc[m][n][0], acc[m][n][1]); o.y = pk2(acc[m][n][2], acc[m][n][3]);
                    *(u32x2v*)(st + (size_t)(16 * n + fr) * 256 + 32 * wv + 16 * m + 4 * fq) = o; }
        }
        if (blk == 7) break;
        for (int half = 0; half < 2; ++half) {
            const int step = 2 * blk + half;
#pragma unroll
            for (int i = 0; i < 8; ++i) { const int id = tid + 512 * i, row = id >> 5, c16 = id & 31; *(LAS v4u*)(Kt + row * 264 + c16 * 8) = pk_[i]; }
#pragma unroll
            for (int i = 0; i < 2; ++i) { const int id = tid + 512 * i, row = id >> 3, c16 = id & 7; *(LAS v4u*)(Vt + row * 72 + c16 * 8) = pv_[i]; }
            __syncthreads();
            if (step + 1 < 14) RS_PREFETCH(step + 1);
#pragma unroll
            for (int ks = 0; ks < 4; ++ks) {
                bf16x8v X[2], Y[4];
#pragma unroll
                for (int m = 0; m < 2; ++m) X[m] = frag_tr(Kt, 264, 32 * ks, 32 * wv + 16 * m, lane);
#pragma unroll
                for (int n = 0; n < 4; ++n) Y[n] = frag_tr(Vt, 72, 32 * ks, 16 * n, lane);
#pragma unroll
                for (int m = 0; m < 2; ++m)
#pragma unroll
                    for (int n = 0; n < 4; ++n) acc[m][n] = __builtin_amdgcn_mfma_f32_16x16x32_bf16(X[m], Y[n], acc[m][n], 0, 0, 0);
            }
            __syncthreads();
        }
#pragma unroll
        for (int m = 0; m < 2; ++m)
#pragma unroll
            for (int n = 0; n < 4; ++n) acc[m][n] = acc[m][n] * cdec;
    }
#undef RS_PREFETCH
}
__device__ __forceinline__ void ret_out(Frame& F) {
    { int t_ = threadIdx.x; asm volatile("" : "+v"(t_)); F.tid = t_; F.lane = t_ & 63; F.wave = __builtin_amdgcn_readfirstlane(t_ >> 6); }
    const int w = F.bx; if (w >= 256) return;
    const int b = w >> 5, h = (w >> 3) & 3, blk = w & 7, tid = F.tid, lane = F.lane, wv = F.wave, fr = lane & 15, fq = lane >> 4;
    LAS unsigned short* Qt = (LAS unsigned short*)F.lds;
    LAS unsigned short* Kt = (LAS unsigned short*)(F.lds + 67584);
    LAS unsigned short* Vt = (LAS unsigned short*)(F.lds + 84480);
    LAS unsigned short* Pt = (LAS unsigned short*)(F.lds + 117760);
    LAS float* red = (LAS float*)(F.lds + 67584);
    const bf16* Q = wsA(F, A_RQ); const bf16* K = wsA(F, A_RK); bf16* V = wsA(F, A_RV);
    const bf16* ST = wsA(F, A_RS) + ((size_t)((b * 4 + h) * 7 + (blk - 1)) * 512) * 256;
    const unsigned R0 = (unsigned)b * SEQ + (unsigned)blk * 256;
    for (int sub = 1; sub >= 0; --sub) {
#pragma unroll
        for (int i = 0; i < 8; ++i) { const int id = tid + 512 * i, row = id >> 5, c16 = id & 31;
            *(LAS v4u*)(Qt + row * 264 + c16 * 8) = *(const v4u*)(Q + (unsigned)((R0 + 128 * sub + row) * 1024 + h * 256 + c16 * 8)); }
        f32x4v acc[8][4];
#pragma unroll
        for (int m = 0; m < 8; ++m)
#pragma unroll
            for (int n = 0; n < 4; ++n) acc[m][n] = (f32x4v){0.f, 0.f, 0.f, 0.f};
        const int nkb = 4 * (sub + 1);
        v4u pk_[2], pv_[4];
#define RO_PREFETCH(kb_) do { _Pragma("unroll") for (int i = 0; i < 2; ++i) { const int id = tid + 512 * i, row = id >> 5, c16 = id & 31; pk_[i] = *(const v4u*)(K + (unsigned)((R0 + 32 * (kb_) + row) * 1024 + h * 256 + c16 * 8)); } \
        _Pragma("unroll") for (int i = 0; i < 4; ++i) { const int id = tid + 512 * i, row = id >> 6, c16 = id & 63; pv_[i] = *(const v4u*)(V + (unsigned)((R0 + 32 * (kb_) + row) * 2048 + h * 512 + c16 * 8)); } } while (0)
        RO_PREFETCH(0);
        for (int kb = 0; kb < nkb; ++kb) {
#pragma unroll
            for (int i = 0; i < 2; ++i) { const int id = tid + 512 * i, row = id >> 5, c16 = id & 31; *(LAS v4u*)(Kt + row * 264 + c16 * 8) = pk_[i]; }
#pragma unroll
            for (int i = 0; i < 4; ++i) { const int id = tid + 512 * i, row = id >> 6, c16 = id & 63; *(LAS v4u*)(Vt + row * 520 + c16 * 8) = pv_[i]; }
            __syncthreads();
            if (kb + 1 < nkb) RO_PREFETCH(kb + 1);
            f32x4v sc[2] = {(f32x4v){0.f, 0.f, 0.f, 0.f}, (f32x4v){0.f, 0.f, 0.f, 0.f}};
#pragma unroll 2
            for (int ks = 0; ks < 8; ++ks) { const bf16x8v Yq = *(const LAS bf16x8v*)(Qt + (16 * wv + fr) * 264 + 32 * ks + 8 * fq);
#pragma unroll
                for (int nt = 0; nt < 2; ++nt) { const bf16x8v Xk = *(const LAS bf16x8v*)(Kt + (16 * nt + fr) * 264 + 32 * ks + 8 * fq); sc[nt] = __builtin_amdgcn_mfma_f32_16x16x32_bf16(Xk, Yq, sc[nt], 0, 0, 0); } }
            const int iloc = 128 * sub + 16 * wv + fr;
#pragma unroll
            for (int nt = 0; nt < 2; ++nt) { const int j0 = 32 * kb + 16 * nt + 4 * fq; float p[4];
#pragma unroll
                for (int e = 0; e < 4; ++e) p[e] = (j0 + e <= iloc) ? sc[nt][e] : 0.f;
                u32x2v o; o.x = pk2(p[0], p[1]); o.y = pk2(p[2], p[3]); *(LAS u32x2v*)(Pt + (16 * wv + fr) * 40 + 16 * nt + 4 * fq) = o; }
            __syncthreads();
            bf16x8v Xv[4];
#pragma unroll
            for (int n = 0; n < 4; ++n) Xv[n] = frag_tr(Vt, 520, 0, 64 * wv + 16 * n, lane);
#pragma unroll
            for (int m = 0; m < 8; ++m) { const bf16x8v Yp = *(const LAS bf16x8v*)(Pt + (16 * m + fr) * 40 + 8 * fq);
#pragma unroll
                for (int n = 0; n < 4; ++n) acc[m][n] = __builtin_amdgcn_mfma_f32_16x16x32_bf16(Xv[n], Yp, acc[m][n], 0, 0, 0); }
            __syncthreads();
        }
        if (blk > 0) {
#pragma unroll 1
            for (int ks = 0; ks < 8; ++ks) { bf16x8v Xs[4];
#pragma unroll
                for (int n = 0; n < 4; ++n) Xs[n] = __builtin_bit_cast(bf16x8v, *(const v4u*)(ST + (unsigned)((64 * wv + 16 * n + fr) * 256 + 32 * ks + 8 * fq)));
#pragma unroll
                for (int m = 0; m < 8; ++m) { const bf16x8v Yq = *(const LAS bf16x8v*)(Qt + (16 * m + fr) * 264 + 32 * ks + 8 * fq);
#pragma unroll
                    for (int n = 0; n < 4; ++n) acc[m][n] = __builtin_amdgcn_mfma_f32_16x16x32_bf16(Xs[n], Yq, acc[m][n], 0, 0, 0); } }
        }
#undef RO_PREFETCH
        float ss[8];
#pragma unroll
        for (int m = 0; m < 8; ++m) { float s = 0.f;
#pragma unroll
            for (int n = 0; n < 4; ++n) s += (acc[m][n][0] * acc[m][n][0] + acc[m][n][1] * acc[m][n][1]) + (acc[m][n][2] * acc[m][n][2] + acc[m][n][3] * acc[m][n][3]);
            s += shx(s, 16, lane); s += shx(s, 32, lane); ss[m] = s; }
        if (fq == 0) {
#pragma unroll
            for (int m = 0; m < 8; ++m) red[wv * 128 + 16 * m + fr] = ss[m]; }
        __syncthreads();
#pragma unroll
        for (int m = 0; m < 8; ++m) { float s = 0.f;
#pragma unroll
            for (int ww = 0; ww < 8; ++ww) s += red[ww * 128 + 16 * m + fr];
            const float rs = 1.0f / sqrtf(s * (1.0f / 512.0f) + 1e-6f);
            bf16* op = V + (unsigned)((R0 + 128 * sub + 16 * m + fr) * 2048 + h * 512 + 64 * wv + 4 * fq);
#pragma unroll
            for (int n = 0; n < 4; ++n) { u32x2v o; o.x = pk2(acc[m][n][0] * rs, acc[m][n][1] * rs); o.y = pk2(acc[m][n][2] * rs, acc[m][n][3] * rs); *(u32x2v*)(op + 16 * n) = o; } }
        __syncthreads();
    }
}
__device__ __forceinline__ bf16x8v frag_tr_perm(const LAS unsigned short* X, int P, int k0, int c0, int lane) {
    const int g = lane >> 4, i = lane & 15, q = i >> 2, p = i & 3;
    const LAS unsigned short* a0 = X + (k0 + 4 * g + q) * P + c0 + 4 * p;
    const v4s16 lo = ds_tr16(a0), hi = ds_tr16(a0 + 16 * P);
    return (bf16x8v){lo[0], lo[1], lo[2], lo[3], hi[0], hi[1], hi[2], hi[3]};
}
__device__ __forceinline__ void swa_mfma(Frame& F) {
    { int t_ = threadIdx.x; asm volatile("" : "+v"(t_)); F.tid = t_; F.lane = t_ & 63; F.wave = __builtin_amdgcn_readfirstlane(t_ >> 6); }
    const int tid = F.tid, lane = F.lane, wv = F.wave, fr = lane & 15, fq = lane >> 4;
    LAS unsigned short* Kt = (LAS unsigned short*)F.lds;
    LAS unsigned short* Vt = (LAS unsigned short*)(F.lds + 36864);
    const bf16* Q = wsA(F, A_SQ); const bf16* K = wsA(F, A_SK); const bf16* V = wsA(F, A_SV); bf16* O = wsA(F, A_SO); const float* sinks = inF(F, I_SWA_SINK);
    for (int i = tid; i < 16 * 72 / 2; i += 512) ((LAS unsigned*)(Vt + 256 * 72))[i] = 0u;
    v4u pkk[4], pvv[4];
#define SW_PREFETCH(it_) do { const int nb_ = (it_) & 15, kvh_ = ((it_) >> 4) & 3, b_ = (it_) >> 6; const long R0_ = (long)b_ * SEQ + nb_ * 128; \
        _Pragma("unroll") for (int i = 0; i < 4; ++i) { const int id = tid + 512 * i, p = id >> 3, c16 = id & 7; pkk[i] = (v4u){0u, 0u, 0u, 0u}; pvv[i] = pkk[i]; \
            if (nb_ > 0 || p >= 128) { pkk[i] = *(const v4u*)(K + (R0_ - 128 + p) * 256 + kvh_ * 64 + c16 * 8); pvv[i] = *(const v4u*)(V + (R0_ - 128 + p) * 256 + kvh_ * 64 + c16 * 8); } } } while (0)
    if (F.bx < BATCH * SWA_HKV * (SEQ / 128)) SW_PREFETCH(F.bx);
    for (int it = F.bx; it < BATCH * SWA_HKV * (SEQ / 128); it += F.G) {
        const int nb = it & 15, kvh = (it >> 4) & 3, b = it >> 6;
        const long R0 = (long)b * SEQ + nb * 128;
#pragma unroll
        for (int i = 0; i < 4; ++i) { const int id = tid + 512 * i, p = id >> 3, c16 = id & 7; *(LAS v4u*)(Kt + p * 72 + c16 * 8) = pkk[i]; *(LAS v4u*)(Vt + p * 72 + c16 * 8) = pvv[i]; }
        __syncthreads();
        if (it + F.G < BATCH * SWA_HKV * (SEQ / 128)) SW_PREFETCH(it + F.G);
        const int qh = kvh * 4 + (wv >> 1); const float sk = sinks[qh] * 1.4426950408889634f;
        bf16x8v Yqa[4][2];
#pragma unroll
        for (int mt = 0; mt < 4; ++mt)
#pragma unroll
            for (int ks = 0; ks < 2; ++ks) Yqa[mt][ks] = __builtin_bit_cast(bf16x8v, *(const v4u*)(Q + (R0 + 64 * (wv & 1) + 16 * mt + fr) * 1024 + qh * 64 + 32 * ks + 8 * fq));
#pragma unroll
        for (int mt = 0; mt < 4; ++mt) {
            const int r = 64 * (wv & 1) + 16 * mt, iloc = r + fr;
            bf16x8v Yq[2] = {Yqa[mt][0], Yqa[mt][1]};
            f32x4v sc[9];
#pragma unroll
            for (int t = 0; t < 9; ++t) { sc[t] = (f32x4v){0.f, 0.f, 0.f, 0.f};
#pragma unroll
                for (int ks = 0; ks < 2; ++ks) { const bf16x8v Xk = *(const LAS bf16x8v*)(Kt + (r + 16 * t + fr) * 72 + 32 * ks + 8 * fq); sc[t] = __builtin_amdgcn_mfma_f32_16x16x32_bf16(Xk, Yq[ks], sc[t], 0, 0, 0); } }
            float mx = -INFINITY;
#pragma unroll
            for (int t = 0; t < 9; ++t)
#pragma unroll
                for (int e = 0; e < 4; ++e) { const int p = r + 16 * t + 4 * fq + e; const bool ok = (p >= iloc + 1) && (p <= iloc + 128) && (nb > 0 || p >= 128);
                    const float s = ok ? sc[t][e] * 1.4426950408889634f : -INFINITY; sc[t][e] = s; mx = fmaxf(mx, s); }
            mx = fmaxf(mx, shx(mx, 16, lane)); mx = fmaxf(mx, shx(mx, 32, lane)); mx = fmaxf(mx, sk);
            float den = 0.f;
#pragma unroll
            for (int t = 0; t < 9; ++t)
#pragma unroll
                for (int e = 0; e < 4; ++e) { const float pe = __builtin_amdgcn_exp2f(sc[t][e] - mx); sc[t][e] = pe; den += pe; }
            den += shx(den, 16, lane); den += shx(den, 32, lane); den += __builtin_amdgcn_exp2f(sk - mx);
            f32x4v o[4];
#pragma unroll
            for (int n = 0; n < 4; ++n) o[n] = (f32x4v){0.f, 0.f, 0.f, 0.f};
#pragma unroll
            for (int s5 = 0; s5 < 5; ++s5) {
                v4u pw; pw.x = pk2(sc[2 * s5][0], sc[2 * s5][1]); pw.y = pk2(sc[2 * s5][2], sc[2 * s5][3]);
                if (s5 < 4) { pw.z = pk2(sc[2 * s5 + 1][0], sc[2 * s5 + 1][1]); pw.w = pk2(sc[2 * s5 + 1][2], sc[2 * s5 + 1][3]); } else { pw.z = 0u; pw.w = 0u; }
                const bf16x8v Yp = __builtin_bit_cast(bf16x8v, pw);
#pragma unroll
                for (int n = 0; n < 4; ++n) { const bf16x8v Xv = frag_tr_perm(Vt, 72, r + 32 * s5, 16 * n, lane); o[n] = __builtin_amdgcn_mfma_f32_16x16x32_bf16(Xv, Yp, o[n], 0, 0, 0); }
            }
            const float inv = 1.0f / den;
            bf16* op = O + (R0 + r + fr) * 1024 + qh * 64 + 4 * fq;
#pragma unroll
            for (int n = 0; n < 4; ++n) { u32x2v ov; ov.x = pk2(o[n][0] * inv, o[n][1] * inv); ov.y = pk2(o[n][2] * inv, o[n][3] * inv); *(u32x2v*)(op + 16 * n) = ov; }
        }
        __syncthreads();
    }
#undef SW_PREFETCH
}
enum Kind { K_PROLOGUE = 0, K_G_RETQKV, K_RET_CORE, K_RET_NORM, K_G_GATE, K_G_RES, K_G_FFNUP, K_G_LRUIN, K_LRU_CONV, K_LRU_SCAN, K_G_SWAQKV, K_SWA_ATT, K_FINAL };
struct PD { int kind, layer, sub; };
constexpr int N_PHASES = 1 + 7 + 6 + 5 + 7 + 1;
__host__ __device__ __forceinline__ int ret_kind(int p) { return p == 0 ? K_G_RETQKV : p == 1 ? K_RET_CORE : p == 2 ? K_RET_NORM : p == 3 ? K_G_GATE : p == 4 ? K_G_RES : p == 5 ? K_G_FFNUP : K_G_RES; }
__host__ __device__ __forceinline__ int lru_kind(int p) { return p == 0 ? K_G_LRUIN : p == 1 ? K_LRU_CONV : p == 2 ? K_LRU_SCAN : p == 3 ? K_G_RES : p == 4 ? K_G_FFNUP : K_G_RES; }
__host__ __device__ __forceinline__ int swa_kind(int p) { return p == 0 ? K_G_SWAQKV : p == 1 ? K_SWA_ATT : p == 2 ? K_G_RES : p == 3 ? K_G_FFNUP : K_G_RES; }
__host__ __device__ __forceinline__ PD phase_desc(int ph) {
    PD d{K_FINAL, 0, 0};
    if (ph == 0) { d.kind = K_PROLOGUE; return d; }
    int p = ph - 1;
    if (p < 7) { d.layer = 0; d.kind = ret_kind(p); d.sub = (p == 6); return d; } p -= 7;
    if (p < 6) { d.layer = 1; d.kind = lru_kind(p); d.sub = (p == 5); return d; } p -= 6;
    if (p < 5) { d.layer = 2; d.kind = swa_kind(p); d.sub = (p == 4); return d; } p -= 5;
    if (p < 7) { d.layer = 3; d.kind = ret_kind(p); d.sub = (p == 6); return d; }
    return d;
}

__global__ void __launch_bounds__(NWAVES * 64, 2) mk_fwd(Args args_unused) {
    extern __shared__ __attribute__((aligned(16))) unsigned char lds[];
    Frame F;
    F.lds = (LAS unsigned char*)lds; F.MISC = (volatile LAS unsigned*)(F.lds + MISC_OFF);
    F.tid = threadIdx.x; F.lane = F.tid & 63; F.wave = __builtin_amdgcn_readfirstlane(F.tid >> 6); F.G = gridDim.x;
    F.ap = (CArgs)__builtin_amdgcn_kernarg_segment_ptr(); F.ws = F.ap->ws; F.ctl = (gu32*)(F.ws + WS_CTL);
    for (int u = F.tid; u < (LDS_BYTES - LDSCTL_OFF) / 4; u += NWAVES * 64) ((LAS unsigned*)(F.lds + LDSCTL_OFF))[u] = 0u;
    __syncthreads();
    XcdBarrier bar = xcd_barrier_post((unsigned*)(F.ctl + CW_BAR) + F.ap->li * XCD_BAR_WORDS, F.MISC + 8);
    const int ph_hi = F.ap->ph_hi;
    for (int ph = F.ap->ph_lo; ph < ph_hi; ++ph) {
        { int bx_ = blockIdx.x; asm volatile("" : "+s"(bx_)); F.bx = bx_; }
        { CArgs ap_ = (CArgs)__builtin_amdgcn_kernarg_segment_ptr(); asm volatile("" : "+s"(ap_)); F.ap = ap_; unsigned char* ws_ = ap_->ws; asm volatile("" : "+s"(ws_)); F.ws = ws_; }
        bf16* XN = (bf16*)(F.ws + WS_XN); float* const outp = F.ap->out;
        const PD d = phase_desc(ph);
        const int L = d.layer, rj = (L == 3) ? 1 : 0;
#ifndef REPMASK
#define REPMASK 0
#endif
        const int nrep = ((REPMASK >> d.kind) & 1) ? 2 : 1;
        for (int rep = 0; rep < nrep; ++rep) {
        if (rep) xcd_barrier(bar);
        switch (d.kind) {
        case K_PROLOGUE: p0_prologue(F); break;
        case K_G_RETQKV: {
            pg8::Gemm g{XN, wsW(F, WO_RETIN + (size_t)rj * 6144 * 1024), M, 4096, 1024}; pg8::StaticOrder S; S.init(M, 4096, F.G, F.bx);
            pg8::EpiRetQKV E{wsA(F, A_RQ), wsA(F, A_RK), wsA(F, A_RV), wsSSQ(F, 2 * L), (const unsigned*)(F.ws + WS_ROPEA)};
            pg8::gemm_phase<pg8::EpiRetQKV, pg8::StaticOrder, true, true>(F.lds, g, S, E);
        } break;
        case K_RET_CORE: ret_state(F); break;
        case K_RET_NORM: ret_out(F); break;
        case K_G_GATE: {
            pg8::Gemm g{XN, wsW(F, WO_RETIN + (size_t)rj * 6144 * 1024 + (size_t)4096 * 1024), M, 2048, 1024}; pg8::StaticOrder S; S.init(M, 2048, F.G, F.bx);
            pg8::EpiGate E{wsA(F, A_RV), wsSSQ(F, 2 * L)};
            pg8::gemm_phase<pg8::EpiGate, pg8::StaticOrder, true, true>(F.lds, g, S, E);
        } break;
        case K_G_RES: {
            const bf16* A; const bf16* W; int K; const float* bias = nullptr; int si;
            if (d.sub == 1) { A = wsA(F, A_H); W = wsW(F, WO_FFNDN + (size_t)L * 1024 * 2816); K = 2816; si = 2 * L + 2; }
            else { si = 2 * L + 1;
                if (L == 1) { A = wsA(F, A_LY); W = wsW(F, WO_LRUOUT); K = 1536; }
                else if (L == 2) { A = wsA(F, A_SO); W = wsW(F, WO_SWAOUT); K = 1024; bias = inF(F, I_SWA_BOUT); }
                else { A = wsA(F, A_RV); W = wsW(F, WO_RETOUT + (size_t)rj * 1024 * 2048); K = 2048; } }
            const float* base = (L == 0 && d.sub == 0) ? inF(F, I_X) : (const float*)outp;
            pg8::Gemm g{A, W, M, 1024, K}; pg8::StaticOrder S; S.init(M, 1024, F.G, F.bx);
            pg8::EpiRes E{base, outp, XN, wsSSQ(F, si), bias};
            pg8::gemm_phase<pg8::EpiRes, pg8::StaticOrder, false, true>(F.lds, g, S, E);
        } break;
        case K_G_FFNUP: {
            pg8::Gemm g{XN, wsW(F, WO_FFNGU + (size_t)L * 5632 * 1024), M, 5632, 1024}; pg8::StaticOrder S; S.init(M, 5632, F.G, F.bx);
            pg8::EpiSwiGLU E{wsA(F, A_H), wsSSQ(F, 2 * L + 1)};
            pg8::gemm_phase<pg8::EpiSwiGLU, pg8::StaticOrder, true, true>(F.lds, g, S, E);
        } break;
        case K_G_LRUIN: {
            pg8::Gemm g{XN, wsW(F, WO_LRUIN), M, 3072, 1024}; pg8::StaticOrder S; S.init(M, 3072, F.G, F.bx);
            pg8::EpiLruIn E{wsA(F, A_LG), wsA(F, A_LU), wsSSQ(F, 2 * L)};
            pg8::gemm_phase<pg8::EpiLruIn, pg8::StaticOrder, true, true>(F.lds, g, S, E);
        } break;
        case K_LRU_CONV: break;
        case K_LRU_SCAN: lru_fused(F); break;
        case K_G_SWAQKV: {
            pg8::Gemm g{XN, wsW(F, WO_SWAQKV), M, 1536, 1024}; pg8::StaticOrder S; S.init(M, 1536, F.G, F.bx);
            pg8::EpiSwaQKV E{wsA(F, A_SQ), wsA(F, A_SK), wsA(F, A_SV), wsSSQ(F, 2 * L), (const unsigned*)(F.ws + WS_ROPEB), inF(F, I_SWA_BQKV)};
            pg8::gemm_phase<pg8::EpiSwaQKV, pg8::StaticOrder, true, true>(F.lds, g, S, E);
        } break;
        case K_SWA_ATT: swa_mfma(F); break;
        default: final_norm(F); break;
        }
        }
        if (ph + 1 < ph_hi) xcd_barrier(bar);
    }
}

extern "C" void kernel_launch(void* const* d_in, const int* in_sizes, int n_in, void* d_out, int out_size, void* d_ws, size_t ws_size, hipStream_t stream) {
    static int grid = 0;
    if (grid == 0) {
        if (n_in != N_IN || in_sizes[0] != M * DM || out_size != M * DM || ws_size < WS_END) { fprintf(stderr, "kernel_launch: unexpected shapes: n_in %d in0 %d out %d ws %zu (need %zu); nothing launched\n", n_in, n_in > 0 ? in_sizes[0] : -1, out_size, ws_size, (size_t)WS_END); grid = -1; return; }
        int dev = 0, cus = 0;
        if (hipGetDevice(&dev) != hipSuccess || hipDeviceGetAttribute(&cus, hipDeviceAttributeMultiprocessorCount, dev) != hipSuccess) { fprintf(stderr, "kernel_launch: device query failed\n"); grid = -1; return; }
        if (hipFuncSetAttribute((const void*)mk_fwd, hipFuncAttributeMaxDynamicSharedMemorySize, LDS_BYTES) != hipSuccess) { fprintf(stderr, "kernel_launch: hipFuncSetAttribute failed\n"); grid = -1; return; }
        int per_cu = 0;
        if (hipOccupancyMaxActiveBlocksPerMultiprocessor(&per_cu, (const void*)mk_fwd, NWAVES * 64, LDS_BYTES) != hipSuccess || per_cu < 1) fprintf(stderr, "kernel_launch: note: occupancy query reports %d workgroups per CU\n", per_cu);
        (void)hipGetLastError();
        grid = cus;
        if (grid != 256) fprintf(stderr, "kernel_launch: note: %d CUs (built for 256)\n", grid);
    }
    if (grid < 0) return;
    if (hipMemsetAsync((char*)d_ws + WS_CTL, 0, CTL_ZERO_BYTES, stream) != hipSuccess) { fprintf(stderr, "kernel_launch: hipMemsetAsync failed\n"); return; }
    Args a{};
    for (int i = 0; i < N_IN; ++i) a.in[i] = d_in[i];
    a.out = (float*)d_out; a.ws = (unsigned char*)d_ws;
#ifndef MK_CUTS
    a.ph_lo = 0; a.ph_hi = N_PHASES; a.li = 0;
    hipLaunchKernelGGL(mk_fwd, dim3(grid), dim3(NWAVES * 64), LDS_BYTES, stream, a);
#else
    for (int ph = 0; ph < N_PHASES; ++ph) { a.ph_lo = ph; a.ph_hi = ph + 1; a.li = 0; hipLaunchKernelGGL(mk_fwd, dim3(grid), dim3(NWAVES * 64), LDS_BYTES, stream, a); }
#endif
    const hipError_t le = hipPeekAtLastError();
    if (le != hipSuccess) fprintf(stderr, "kernel_launch: launch failed: %s\n", hipGetErrorName(le));
}
```
